# Optimizing an MI355X kernel written in HIP

```python
import math
import jax, jax.numpy as jnp
from jax import lax
import numpy as np

D_MODEL = 2048
BATCH = 32
SEQ = 256
DEPTH = 4
DEC_BATCH = 8
DEC_SEQ = 2048
PAST_LEN = 256

GRID_W = 64
BLOCK = 128
EPS = 1e-6
NEG_INF = -1e30
RET_HEADS = 4
RET_DK = 128
RET_DV = 128
RET_WIDTH = RET_HEADS * RET_DV
LRU_WIDTH = 512
LRU_BLOCKS = 4
LRU_BLOCK_DIM = LRU_WIDTH // LRU_BLOCKS
CONV_W = 4
CONV_LEFT = 2
LRU_C = 8.0
ATT_Q_HEADS = 4
ATT_KV_HEADS = 2
ATT_GROUP = ATT_Q_HEADS // ATT_KV_HEADS
HEAD_DIM = 128
WINDOW = 128
ROPE_BASE = 10000.0
SSM_WIDTH = 512
SSM_GROUP = 16
SSM_GROUPS = SSM_WIDTH // SSM_GROUP
SSM_STATE = 64
N_BRANCH = 4
BRANCH_WIDTH = 512
D_FF = 4 * D_MODEL
IN_SIZES = (RET_WIDTH, RET_WIDTH, RET_WIDTH, RET_WIDTH, LRU_WIDTH, LRU_WIDTH,
            ATT_Q_HEADS * HEAD_DIM, ATT_KV_HEADS * HEAD_DIM, ATT_KV_HEADS * HEAD_DIM,
            SSM_WIDTH, N_BRANCH * D_MODEL)
IN_TOTAL = 4 * RET_WIDTH + 2 * LRU_WIDTH + (ATT_Q_HEADS + 2 * ATT_KV_HEADS) * HEAD_DIM + SSM_WIDTH + N_BRANCH * D_MODEL

kernel_name = "hybrid_diffusion_prefix_trunk_step"


def rms_norm(x, g):
    xf = x.astype(jnp.float32)
    y = xf * lax.rsqrt(jnp.mean(xf * xf, axis=-1, keepdims=True) + EPS)
    return (y * g.astype(jnp.float32)).astype(x.dtype)


def linear_scan(a, b, h0):
    b = b.at[:, 0].add(a[:, 0] * h0)
    def comb(l, r):
        return (l[0] * r[0], r[0] * l[1] + r[1])
    _, h = lax.associative_scan(comb, (a, b), axis=1)
    return h


def retention_scan(q, k, v, log_gamma, s0):
    B_, L = q.shape[:2]
    n = L // BLOCK
    qc = q.reshape(B_, n, BLOCK, RET_HEADS, RET_DK)
    kc = k.reshape(B_, n, BLOCK, RET_HEADS, RET_DK)
    vc = v.reshape(B_, n, BLOCK, RET_HEADS, RET_DV)
    idx = jnp.arange(BLOCK, dtype=jnp.float32)
    rel = idx[:, None] - idx[None, :]
    decay = jnp.where(rel >= 0, jnp.exp(jnp.maximum(rel, 0.0)[None] * log_gamma[:, None, None]), 0.0)
    scores = jnp.einsum('bnihd,bnjhd->bnhij', qc, kc) * decay
    intra = jnp.einsum('bnhij,bnjhe->bnihe', scores, vc)
    w_end = jnp.exp((BLOCK - 1 - idx)[:, None] * log_gamma[None, :])
    kv = jnp.einsum('bnjhd,bnjhe->bnhde', kc * w_end[..., None], vc)
    chunk_decay = jnp.exp(BLOCK * log_gamma)[:, None, None]
    def step(s, kv_n):
        return chunk_decay * s + kv_n, s
    s_last, s_in = lax.scan(step, s0, jnp.moveaxis(kv, 1, 0))
    w_in = jnp.exp((idx + 1)[:, None] * log_gamma[None, :])
    cross = jnp.einsum('bnihd,bnhde->bnihe', qc * w_in[..., None], jnp.moveaxis(s_in, 0, 1))
    return (intra + cross).reshape(B_, L, RET_HEADS, RET_DV), s_last


def retention(q, k, v, g, decay_logit, gn_gain, s0):
    B_, L, _ = q.shape
    f32 = jnp.float32
    q = q.astype(f32).reshape(B_, L, RET_HEADS, RET_DK) * RET_DK ** -0.5
    k = k.astype(f32).reshape(B_, L, RET_HEADS, RET_DK)
    v = v.astype(f32).reshape(B_, L, RET_HEADS, RET_DV)
    log_gamma = -jax.nn.softplus(-decay_logit.astype(f32))
    o_f, s_f = retention_scan(q, k, v, log_gamma[0], s0[:, 0])
    o_b, s_b = retention_scan(jnp.flip(q, 1), jnp.flip(k, 1), jnp.flip(v, 1), log_gamma[1], s0[:, 1])
    o = o_f + jnp.flip(o_b, 1)
    mu = jnp.mean(o, axis=-1, keepdims=True)
    var = jnp.mean(jnp.square(o - mu), axis=-1, keepdims=True)
    o = ((o - mu) * lax.rsqrt(var + EPS)).reshape(B_, L, RET_WIDTH) * gn_gain.astype(f32)
    return jax.nn.silu(g.astype(f32)) * o, jnp.stack([s_f, s_b], axis=1)


def centred_conv(x, w, b):
    L = x.shape[1]
    xp = jnp.pad(x, ((0, 0), (CONV_LEFT, CONV_W - 1 - CONV_LEFT), (0, 0)))
    return sum(xp[:, j:j + L] * w[j] for j in range(CONV_W)) + b


def rglru_scan(x, w_a, b_a, w_x, b_x, lam, h0):
    B_, L, _ = x.shape
    xb = x.reshape(B_, L, LRU_BLOCKS, LRU_BLOCK_DIM)
    r = jax.nn.sigmoid(jnp.einsum('blnd,nde->blne', xb, w_a).reshape(B_, L, LRU_WIDTH) + b_a)
    i = jax.nn.sigmoid(jnp.einsum('blnd,nde->blne', xb, w_x).reshape(B_, L, LRU_WIDTH) + b_x)
    log_a = -LRU_C * r * jax.nn.softplus(-lam.astype(jnp.float32))
    a = jnp.exp(log_a)
    b = jnp.sqrt(-jnp.expm1(2.0 * log_a)) * (i * x)
    return linear_scan(a, b, h0)


def rglru_mixer(x, gate, p, s0):
    xc = centred_conv(x, p['lru_conv_w'], p['lru_conv_b']).astype(jnp.float32)
    outs, finals = [], []
    for d in range(2):
        xd = xc if d == 0 else jnp.flip(xc, 1)
        h = rglru_scan(xd, p['lru_wa'][d], p['lru_ba'][d], p['lru_wx'][d], p['lru_bx'][d], p['lru_lambda'][d], s0[:, d])
        finals.append(h[:, -1])
        outs.append(h if d == 0 else jnp.flip(h, 1))
    y = jax.nn.gelu(gate.astype(jnp.float32)) * (outs[0] + outs[1])
    return y, jnp.stack(finals, axis=1)


def axial_rope(x):
    L = x.shape[1]
    t = jnp.arange(L)
    row = (t // GRID_W).astype(jnp.float32)
    col = (t % GRID_W).astype(jnp.float32)
    n_pairs = HEAD_DIM // 4
    freqs = ROPE_BASE ** (-jnp.arange(n_pairs, dtype=jnp.float32) / n_pairs)
    ang = jnp.concatenate([row[:, None] * freqs, col[:, None] * freqs], axis=-1)
    cos = jnp.cos(ang)[None, :, None, :].astype(x.dtype)
    sin = jnp.sin(ang)[None, :, None, :].astype(x.dtype)
    x1, x2 = x[..., :HEAD_DIM // 2], x[..., HEAD_DIM // 2:]
    return jnp.concatenate([x1 * cos - x2 * sin, x2 * cos + x1 * sin], axis=-1)


def sink_attend(q, k, v, sink, mask):
    s = jnp.einsum('bqkgd,bskd->bkgqs', q, k).astype(jnp.float32) * HEAD_DIM ** -0.5
    if mask is not None:
        s = jnp.where(mask, s, NEG_INF)
    snk = sink.astype(jnp.float32)[None, :, :, None, None]
    m = jnp.maximum(jnp.max(s, axis=-1, keepdims=True), snk)
    pr = jnp.exp(s - m)
    denom = jnp.sum(pr, axis=-1, keepdims=True) + jnp.exp(snk - m)
    return jnp.einsum('bkgqs,bskd->bqkgd', (pr / denom).astype(v.dtype), v)


def context_attention(q, k, v, sink):
    B_, L = q.shape[:2]
    n = L // BLOCK
    qb = jnp.moveaxis(q.reshape(B_, n, BLOCK, ATT_KV_HEADS, ATT_GROUP, HEAD_DIM), 1, 0)
    snk = sink.reshape(ATT_KV_HEADS, ATT_GROUP)
    out = lax.map(lambda qi: sink_attend(qi, k, v, snk, None), qb)
    return jnp.moveaxis(out, 0, 1).reshape(B_, L, ATT_Q_HEADS * HEAD_DIM)


def latent_attention(q, k, v, ck, cv, sink):
    B_, L = q.shape[:2]
    n = L // BLOCK
    P = ck.shape[1]
    qg = q.reshape(B_, L, ATT_KV_HEADS, ATT_GROUP, HEAD_DIM)
    pad = ((0, 0), (BLOCK, BLOCK), (0, 0), (0, 0))
    kp, vp = jnp.pad(k, pad), jnp.pad(v, pad)
    snk = sink.reshape(ATT_KV_HEADS, ATT_GROUP)
    off = jnp.arange(BLOCK)[:, None] - jnp.arange(3 * BLOCK)[None, :] + BLOCK
    ctx_mask = jnp.ones((BLOCK, P), dtype=bool)
    def blk(i):
        start = i * BLOCK
        qi = lax.dynamic_slice_in_dim(qg, start, BLOCK, axis=1)
        ki = lax.dynamic_slice_in_dim(kp, start, 3 * BLOCK, axis=1)
        vi = lax.dynamic_slice_in_dim(vp, start, 3 * BLOCK, axis=1)
        kpos = start - BLOCK + jnp.arange(3 * BLOCK)
        band = (jnp.abs(off) <= WINDOW) & ((kpos >= 0) & (kpos < L))[None, :]
        mask = jnp.concatenate([band, ctx_mask], axis=1)
        return sink_attend(qi, jnp.concatenate([ki, ck], axis=1), jnp.concatenate([vi, cv], axis=1), snk, mask)
    out = lax.map(blk, jnp.arange(n))
    return jnp.moveaxis(out, 0, 1).reshape(B_, L, ATT_Q_HEADS * HEAD_DIM)


def s5_scan(u, a_re, a_im, log_dt, b_re, b_im, c_re, c_im, h0):
    f32 = jnp.float32
    B_, L, _ = u.shape
    lam = lax.complex(a_re.astype(f32), a_im.astype(f32))
    dt = jnp.exp(log_dt.astype(f32))[:, None]
    a_bar = jnp.exp(lam * dt)
    b_bar = ((a_bar - 1.0) / lam)[..., None] * lax.complex(b_re.astype(f32), b_im.astype(f32))
    ug = u.reshape(B_, L, SSM_GROUPS, SSM_GROUP).astype(jnp.complex64)
    bu = jnp.einsum('blgc,gpc->blgp', ug, b_bar)
    a_seq = jnp.broadcast_to(a_bar, (1, L, SSM_GROUPS, SSM_STATE))
    h = linear_scan(a_seq, bu, h0)
    y = jnp.einsum('blgp,gcp->blgc', h, lax.complex(c_re.astype(f32), c_im.astype(f32))).real
    return y.reshape(B_, L, SSM_WIDTH), h[:, -1]


def s5_mixer(u, p, s0):
    f32 = jnp.float32
    uf = u.astype(f32)
    outs, finals = [], []
    for d in range(2):
        ud = uf if d == 0 else jnp.flip(uf, 1)
        y, hl = s5_scan(ud, p['ssm_a_re'][d], p['ssm_a_im'][d], p['ssm_log_dt'][d], p['ssm_b_re'][d],
                        p['ssm_b_im'][d], p['ssm_c_re'][d], p['ssm_c_im'][d], s0[:, d])
        finals.append(hl)
        outs.append(y if d == 0 else jnp.flip(y, 1))
    y = jax.nn.gelu(outs[0] + outs[1] + p['ssm_d'].astype(f32) * uf)
    out = y * jax.nn.sigmoid(y @ p['ssm_w_glu'].astype(f32) + p['ssm_b_glu'].astype(f32))
    return out, jnp.stack(finals, axis=1)


def token_mixers(h, p, ctx_cache):
    f32 = jnp.float32
    B_, L, _ = h.shape
    is_ctx = ctx_cache is None
    offs = [int(o) for o in np.cumsum(IN_SIZES)[:-1]]
    rq, rk, rv, rg, lx, lgate, aq, ak, av, su, gates = jnp.split(h @ p['w_in'], offs, axis=-1)
    if is_ctx:
        s_ret0 = jnp.zeros((B_, 2, RET_HEADS, RET_DK, RET_DV), f32)
        s_lru0 = jnp.zeros((B_, 2, LRU_WIDTH), f32)
        s_ssm0 = jnp.zeros((B_, 2, SSM_GROUPS, SSM_STATE), jnp.complex64)
    else:
        ck, cv, s_ret0, s_lru0, s_re0, s_im0 = ctx_cache
        s_ret0 = s_ret0.astype(f32)
        s_lru0 = s_lru0.astype(f32)
        s_ssm0 = lax.complex(s_re0.astype(f32), s_im0.astype(f32))
    o_ret, s_ret = retention(rq, rk, rv, rg, p['ret_decay_logit'], p['ret_gn'], s_ret0)
    o_lru, s_lru = rglru_mixer(lx, lgate, p, s_lru0)
    q = rms_norm(aq.reshape(B_, L, ATT_Q_HEADS, HEAD_DIM), p['att_q_norm'])
    k = rms_norm(ak.reshape(B_, L, ATT_KV_HEADS, HEAD_DIM), p['att_k_norm'])
    v = av.reshape(B_, L, ATT_KV_HEADS, HEAD_DIM)
    if is_ctx:
        o_att = context_attention(q, k, v, p['att_sink'])
    else:
        o_att = latent_attention(axial_rope(q), axial_rope(k), v, ck.astype(k.dtype), cv.astype(v.dtype), p['att_sink'])
    o_ssm, s_ssm = s5_mixer(su, p, s_ssm0)
    g = gates.reshape(B_, L, N_BRANCH, D_MODEL)
    merged = 0.0
    for n_b, o_b in enumerate((o_ret, o_lru, o_att, o_ssm)):
        merged = merged + jax.nn.sigmoid(g[:, :, n_b]) * (o_b.astype(h.dtype) @ p['w_br'][n_b])
    out = merged @ p['w_out']
    if is_ctx:
        return out, (k, v, s_ret, s_lru, s_ssm.real, s_ssm.imag)
    return out, None


def trunk_layer(x, cond, p, ctx_cache):
    mod = jax.nn.silu(cond) @ p['w_mod'] + p['b_mod']
    sh1, sc1, g1, sh2, sc2, g2 = jnp.split(mod[:, None, :], 6, axis=-1)
    h = rms_norm(x, p['norm1']) * (1.0 + sc1) + sh1
    out, st = token_mixers(h, p, ctx_cache)
    x = x + g1 * out
    h = rms_norm(x, p['norm2']) * (1.0 + sc2) + sh2
    f = jnp.square(jax.nn.relu(h @ p['w_ff1'])) @ p['w_ff2']
    return x + g2 * f, st


def setup_inputs(seed: int = 0) -> dict:
    key = jax.random.key(seed)
    keys = iter(jax.random.split(key, 64))
    f32 = jnp.float32
    def nrm(shape, scale):
        return jax.random.normal(next(keys), shape, f32) * scale
    def unif(shape, lo, hi):
        return jax.random.uniform(next(keys), shape, f32, lo, hi)
    gam = 1.0 - 2.0 ** (-5.0 - jnp.arange(RET_HEADS, dtype=f32))
    a0 = unif((DEPTH, 2, LRU_WIDTH), 0.9, 0.999)
    return {
        'x_prompt': nrm((BATCH, SEQ, D_MODEL), 1.0),
        'x_sample': nrm((DEC_BATCH, DEC_SEQ, D_MODEL), 1.0),
        'cache_attn_k': nrm((DEC_BATCH, DEPTH, PAST_LEN, ATT_KV_HEADS, HEAD_DIM), 1.0),
        'cache_attn_v': nrm((DEC_BATCH, DEPTH, PAST_LEN, ATT_KV_HEADS, HEAD_DIM), 1.0),
        'state_ret': nrm((DEC_BATCH, DEPTH, 2, RET_HEADS, RET_DK, RET_DV), 1.0),
        'state_lru': nrm((DEC_BATCH, DEPTH, 2, LRU_WIDTH), 0.5),
        'state_ssm_re': nrm((DEC_BATCH, DEPTH, 2, SSM_GROUPS, SSM_STATE), 0.1),
        'state_ssm_im': nrm((DEC_BATCH, DEPTH, 2, SSM_GROUPS, SSM_STATE), 0.1),
        'c': nrm((DEC_BATCH, D_MODEL), 1.0),
        'c_ctx': nrm((D_MODEL,), 1.0),
        'w_mod': nrm((DEPTH, D_MODEL, 6 * D_MODEL), 0.5 * D_MODEL ** -0.5),
        'b_mod': nrm((DEPTH, 6 * D_MODEL), 0.02),
        'norm1': 1.0 + nrm((DEPTH, D_MODEL), 0.02),
        'w_in': nrm((DEPTH, D_MODEL, IN_TOTAL), D_MODEL ** -0.5),
        'ret_decay_logit': jnp.log(gam / (1.0 - gam)) + nrm((DEPTH, 2, RET_HEADS), 0.1),
        'ret_gn': 1.0 + nrm((DEPTH, RET_WIDTH), 0.02),
        'lru_conv_w': nrm((DEPTH, CONV_W, LRU_WIDTH), CONV_W ** -0.5),
        'lru_conv_b': nrm((DEPTH, LRU_WIDTH), 0.02),
        'lru_wa': nrm((DEPTH, 2, LRU_BLOCKS, LRU_BLOCK_DIM, LRU_BLOCK_DIM), LRU_BLOCK_DIM ** -0.5),
        'lru_ba': nrm((DEPTH, 2, LRU_WIDTH), 0.02),
        'lru_wx': nrm((DEPTH, 2, LRU_BLOCKS, LRU_BLOCK_DIM, LRU_BLOCK_DIM), LRU_BLOCK_DIM ** -0.5),
        'lru_bx': nrm((DEPTH, 2, LRU_WIDTH), 0.02),
        'lru_lambda': jnp.log(a0 / (1.0 - a0)),
        'att_q_norm': 1.0 + nrm((DEPTH, HEAD_DIM), 0.02),
        'att_k_norm': 1.0 + nrm((DEPTH, HEAD_DIM), 0.02),
        'att_sink': nrm((DEPTH, ATT_Q_HEADS), 0.5),
        'ssm_a_re': -0.5 + nrm((DEPTH, 2, SSM_GROUPS, SSM_STATE), 0.01),
        'ssm_a_im': math.pi * jnp.arange(SSM_STATE, dtype=f32) + nrm((DEPTH, 2, SSM_GROUPS, SSM_STATE), 0.01),
        'ssm_log_dt': unif((DEPTH, 2, SSM_GROUPS), math.log(1e-3), math.log(1e-1)),
        'ssm_b_re': nrm((DEPTH, 2, SSM_GROUPS, SSM_STATE, SSM_GROUP), (2 * SSM_GROUP) ** -0.5),
        'ssm_b_im': nrm((DEPTH, 2, SSM_GROUPS, SSM_STATE, SSM_GROUP), (2 * SSM_GROUP) ** -0.5),
        'ssm_c_re': nrm((DEPTH, 2, SSM_GROUPS, SSM_GROUP, SSM_STATE), SSM_STATE ** -0.5),
        'ssm_c_im': nrm((DEPTH, 2, SSM_GROUPS, SSM_GROUP, SSM_STATE), SSM_STATE ** -0.5),
        'ssm_d': nrm((DEPTH, SSM_WIDTH), 1.0),
        'ssm_w_glu': nrm((DEPTH, SSM_WIDTH, SSM_WIDTH), SSM_WIDTH ** -0.5),
        'ssm_b_glu': nrm((DEPTH, SSM_WIDTH), 0.02),
        'w_br': nrm((DEPTH, N_BRANCH, BRANCH_WIDTH, D_MODEL), BRANCH_WIDTH ** -0.5),
        'w_out': nrm((DEPTH, D_MODEL, D_MODEL), D_MODEL ** -0.5),
        'norm2': 1.0 + nrm((DEPTH, D_MODEL), 0.02),
        'w_ff1': nrm((DEPTH, D_MODEL, D_FF), D_MODEL ** -0.5),
        'w_ff2': nrm((DEPTH, D_FF, D_MODEL), D_FF ** -0.5),
    }


def reference(x_prompt, x_sample, cache_attn_k, cache_attn_v, state_ret, state_lru, state_ssm_re, state_ssm_im,
              c, c_ctx, w_mod, b_mod, norm1, w_in, ret_decay_logit, ret_gn, lru_conv_w, lru_conv_b,
              lru_wa, lru_ba, lru_wx, lru_bx, lru_lambda, att_q_norm, att_k_norm, att_sink,
              ssm_a_re, ssm_a_im, ssm_log_dt, ssm_b_re, ssm_b_im, ssm_c_re, ssm_c_im, ssm_d,
              ssm_w_glu, ssm_b_glu, w_br, w_out, norm2, w_ff1, w_ff2):
    y_prompt, y_sample = x_prompt, x_sample
    cond_ctx = c_ctx[None, :]
    ks, vs, rets, lrus, sres, sims = [], [], [], [], [], []
    for l in range(DEPTH):
        p = {
            'w_mod': w_mod[l], 'b_mod': b_mod[l], 'norm1': norm1[l], 'w_in': w_in[l],
            'ret_decay_logit': ret_decay_logit[l], 'ret_gn': ret_gn[l],
            'lru_conv_w': lru_conv_w[l], 'lru_conv_b': lru_conv_b[l], 'lru_wa': lru_wa[l], 'lru_ba': lru_ba[l],
            'lru_wx': lru_wx[l], 'lru_bx': lru_bx[l], 'lru_lambda': lru_lambda[l],
            'att_q_norm': att_q_norm[l], 'att_k_norm': att_k_norm[l], 'att_sink': att_sink[l],
            'ssm_a_re': ssm_a_re[l], 'ssm_a_im': ssm_a_im[l], 'ssm_log_dt': ssm_log_dt[l],
            'ssm_b_re': ssm_b_re[l], 'ssm_b_im': ssm_b_im[l], 'ssm_c_re': ssm_c_re[l], 'ssm_c_im': ssm_c_im[l],
            'ssm_d': ssm_d[l], 'ssm_w_glu': ssm_w_glu[l], 'ssm_b_glu': ssm_b_glu[l],
            'w_br': w_br[l], 'w_out': w_out[l], 'norm2': norm2[l], 'w_ff1': w_ff1[l], 'w_ff2': w_ff2[l],
        }
        y_prompt, st = trunk_layer(y_prompt, cond_ctx, p, None)
        ks.append(st[0]); vs.append(st[1]); rets.append(st[2]); lrus.append(st[3]); sres.append(st[4]); sims.append(st[5])
        cache_l = (cache_attn_k[:, l], cache_attn_v[:, l], state_ret[:, l], state_lru[:, l],
                   state_ssm_re[:, l], state_ssm_im[:, l])
        y_sample, _ = trunk_layer(y_sample, c, p, cache_l)
    new_attn_k = jnp.stack(ks, axis=1)
    new_attn_v = jnp.stack(vs, axis=1)
    new_ret = jnp.stack(rets, axis=1)
    new_lru = jnp.stack(lrus, axis=1)
    new_ssm_re = jnp.stack(sres, axis=1)
    new_ssm_im = jnp.stack(sims, axis=1)
    return (y_prompt, y_sample, new_attn_k, new_attn_v, new_ret, new_lru, new_ssm_re, new_ssm_im)
```

```cpp
#include <hip/hip_runtime.h>
#include <cstdio>
#include <cstdint>

#define LAS __attribute__((address_space(3)))
typedef unsigned short bf16_t;
typedef short bf16x8 __attribute__((ext_vector_type(8)));
typedef short s16x4 __attribute__((ext_vector_type(4)));
typedef float f32x4 __attribute__((ext_vector_type(4)));
typedef float f32x2 __attribute__((ext_vector_type(2)));
typedef unsigned u32x4 __attribute__((ext_vector_type(4)));
typedef unsigned u32x2 __attribute__((ext_vector_type(2)));

namespace pg8 {
constexpr int BM = 256, BK = 64, HALF = 128, HTB = HALF * BK * 2, STAGE_BYTES = 8 * HTB, NXCD = 8, WGM = 8;
__host__ __device__ __forceinline__ int lds_byte(int r, int c) { const int st = (r >> 4) * 2 + (c >> 5), rr = r & 15, cc = c & 31, ob = rr * 64 + cc * 2; return st * 1024 + (ob ^ (((ob >> 9) & 1) << 5)); }
__host__ __device__ __forceinline__ void stage_rc(int b, int& R, int& C) { const int st = b / 1024, sb = b % 1024, swz = sb ^ (((sb >> 9) & 1) << 5); R = (st >> 1) * 16 + swz / 64; C = (st & 1) * 32 + (swz % 64) / 2; }
__host__ __device__ __forceinline__ int perm32(int rho) { const int n = rho >> 4, i = rho & 15; return 8 * (i >> 2) + 4 * n + (i & 3); }
struct Unit { int pm, pn; };
struct Gemm { const bf16_t* A; const bf16_t* Bt; int M, N, K, lda, ldb, a_grp, a_gstride; };
struct StaticOrder {
    int nM, nN, nwg, G, c;
    __host__ __device__ void init(int M, int N, int G_, int c_) { nM = M / BM; nN = N / BM; nwg = nM * nN; G = G_; c = c_; }
    __host__ __device__ bool next(int i, Unit& u) const {
        const long L = (long)i * G + c; if (L >= nwg) return false;
        int wgid = (int)L; { const int q = nwg / NXCD, r = nwg % NXCD, xcd = wgid % NXCD, off = wgid / NXCD; wgid = (xcd < r ? xcd * (q + 1) : r * (q + 1) + (xcd - r) * q) + off; }
        const int nig = WGM * nN, gid = wgid / nig, fm = gid * WGM, gsz = (nM - fm) < WGM ? (nM - fm) : WGM;
        u.pm = fm + ((wgid % nig) % gsz); u.pn = (wgid % nig) / gsz; return true;
    }
};
__device__ __forceinline__ unsigned cvt_pk_bf16(float lo, float hi) { unsigned r; asm volatile("v_cvt_pk_bf16_f32 %0, %1, %2" : "=v"(r) : "v"(lo), "v"(hi)); return r; }

template <class Epi>
__device__ __forceinline__ void gemm_phase(LAS unsigned char* lds, const Gemm g, const StaticOrder& S, const Epi& E) {
    int tid = threadIdx.x; asm volatile("" : "+v"(tid)); const int wid = __builtin_amdgcn_readfirstlane(tid >> 6), lane = tid & 63, wr = wid >> 2, wc = wid & 3, fr = lane & 15, fq = lane >> 4;
    const int K = g.K, nt = K / BK;
    unsigned voffA[2], voffB[2];
#pragma unroll
    for (int i = 0; i < 2; ++i) { int R, C; stage_rc(tid * 16 + i * 8192, R, C); const int Rb = Epi::PERM ? ((R & ~31) + perm32(R & 31)) : R;
        voffA[i] = (unsigned)(R * g.lda + C) * 2u; voffB[i] = (unsigned)(Rb * g.ldb + C) * 2u; }
    const size_t kstep = (size_t)(BK * 2);
    const size_t hsA = (size_t)HALF * g.lda * 2, hsB = (size_t)HALF * g.ldb * 2;
    const unsigned ldsw = (unsigned)wid * 1024u;
    const int aoff = lds_byte(wr * 64 + fr, fq * 8), boff = lds_byte(wc * 32 + fr, fq * 8);
#define PG8_SA(b, h) (((b) * 2 + (h)) * HTB)
#define PG8_SB(b, h) ((4 + (b) * 2 + (h)) * HTB)
#define PG8_STAGE(bufoff, gbase, voff) do { _Pragma("unroll") for (int _i = 0; _i < 2; ++_i) \
        __builtin_amdgcn_global_load_lds((const unsigned*)((const char*)(gbase) + (voff)[_i]), (LAS unsigned*)(lds + (bufoff) + ldsw + _i * 8192), 16, 0, 0); } while (0)
#define PG8_LDA(dst, b, h) do { _Pragma("unroll") for (int m = 0; m < 4; ++m) _Pragma("unroll") for (int k = 0; k < 2; ++k) dst[m][k] = *(const LAS bf16x8*)(lds + PG8_SA(b, h) + aoff + m * 2048 + k * 1024); } while (0)
#define PG8_LDB(dst, b, h) do { _Pragma("unroll") for (int n = 0; n < 2; ++n) _Pragma("unroll") for (int k = 0; k < 2; ++k) dst[n][k] = *(const LAS bf16x8*)(lds + PG8_SB(b, h) + boff + n * 2048 + k * 1024); } while (0)
#define PG8_MMA(ai, bj, At, Bt) do { __builtin_amdgcn_s_setprio(1); _Pragma("unroll") for (int m = 0; m < 4; ++m) _Pragma("unroll") for (int n = 0; n < 2; ++n) _Pragma("unroll") for (int k = 0; k < 2; ++k) \
        acc[ai][bj][m][n] = __builtin_amdgcn_mfma_f32_16x16x32_bf16(Bt[n][k], At[m][k], acc[ai][bj][m][n], 0, 0, 0); __builtin_amdgcn_s_setprio(0); } while (0)
#define PG8_WAIT_V(n) asm volatile("s_waitcnt vmcnt(" #n ")" ::: "memory")
#define PG8_WAIT_L(n) asm volatile("s_waitcnt lgkmcnt(" #n ")" ::: "memory")
#define PG8_BAR __builtin_amdgcn_s_barrier()
#define PG8_SCHED __builtin_amdgcn_sched_barrier(0)
#define PG8_UA(u) ((const char*)g.A + (size_t)(u).pm * 2 * hsA + (size_t)(((u).pn / g.a_grp) * g.a_gstride) * 2)
#define PG8_UB(u) ((const char*)g.Bt + (size_t)(u).pn * 2 * hsB)
    Unit cur, nxt; int ui = 0;
    if (!S.next(0, cur)) return;
    f32x4 acc[2][2][4][2];
#pragma unroll
    for (int a = 0; a < 2; ++a)
#pragma unroll
        for (int b = 0; b < 2; ++b)
#pragma unroll
            for (int m = 0; m < 4; ++m)
#pragma unroll
                for (int n = 0; n < 2; ++n) acc[a][b][m][n] = (f32x4){0.f, 0.f, 0.f, 0.f};
    bf16x8 At[4][2], B0[2][2], B1[2][2];
    const char* cA = PG8_UA(cur); const char* cB = PG8_UB(cur);
    PG8_STAGE(PG8_SB(0, 0), cB, voffB); PG8_STAGE(PG8_SB(0, 1), cB + hsB, voffB); PG8_STAGE(PG8_SA(0, 0), cA, voffA); PG8_STAGE(PG8_SA(0, 1), cA + hsA, voffA);
    if (wr == 1) PG8_BAR;
    PG8_WAIT_V(2); PG8_BAR;
    PG8_STAGE(PG8_SB(1, 0), cB + kstep, voffB); PG8_STAGE(PG8_SA(1, 0), cA + kstep, voffA); PG8_STAGE(PG8_SB(1, 1), cB + hsB + kstep, voffB);
    PG8_WAIT_V(6); PG8_BAR;
    for (;;) {
        const bool has_next = S.next(ui + 1, nxt);
        const char* nA = has_next ? PG8_UA(nxt) : cA; const char* nB = has_next ? PG8_UB(nxt) : cB;
        for (int t = 0; t < nt; t += 2) {
            const bool last = (t == nt - 2);
            const char* a1 = cA + (size_t)(t + 1) * kstep;
            const char* a2 = last ? nA : cA + (size_t)(t + 2) * kstep; const char* b2 = last ? nB : cB + (size_t)(t + 2) * kstep;
            const char* a3 = a2 + kstep; const char* b3 = b2 + kstep;
            PG8_LDB(B0, 0, 0); PG8_LDB(B1, 0, 1); PG8_SCHED; PG8_LDA(At, 0, 0); PG8_STAGE(PG8_SA(1, 1), a1 + hsA, voffA);
            PG8_WAIT_V(8); PG8_WAIT_L(0); PG8_BAR; PG8_MMA(0, 0, At, B0); PG8_MMA(0, 1, At, B1); PG8_BAR; PG8_SCHED;
            PG8_LDA(At, 0, 1); PG8_STAGE(PG8_SB(0, 0), b2, voffB); PG8_STAGE(PG8_SB(0, 1), b2 + hsB, voffB); PG8_STAGE(PG8_SA(0, 0), a2, voffA);
            PG8_WAIT_V(8); PG8_WAIT_L(0); PG8_BAR; PG8_MMA(1, 0, At, B0); PG8_MMA(1, 1, At, B1); PG8_BAR; PG8_SCHED;
            PG8_LDB(B0, 1, 0); PG8_LDB(B1, 1, 1); PG8_SCHED; PG8_LDA(At, 1, 0); PG8_STAGE(PG8_SA(0, 1), a2 + hsA, voffA);
            PG8_WAIT_V(8); PG8_WAIT_L(0); PG8_BAR; PG8_MMA(0, 0, At, B0); PG8_MMA(0, 1, At, B1); PG8_BAR; PG8_SCHED;
            PG8_LDA(At, 1, 1); PG8_STAGE(PG8_SB(1, 0), b3, voffB); PG8_STAGE(PG8_SB(1, 1), b3 + hsB, voffB); PG8_STAGE(PG8_SA(1, 0), a3, voffA);
            PG8_WAIT_V(8); PG8_WAIT_L(0); PG8_BAR; PG8_MMA(1, 0, At, B0); PG8_MMA(1, 1, At, B1); PG8_BAR; PG8_SCHED;
        }
        if (wr == 0) PG8_BAR;
        E(acc, cur, wr, wc, fr, fq);
        if (!has_next) break;
#pragma unroll
        for (int a = 0; a < 2; ++a)
#pragma unroll
            for (int b = 0; b < 2; ++b)
#pragma unroll
                for (int m = 0; m < 4; ++m)
#pragma unroll
                    for (int n = 0; n < 2; ++n) acc[a][b][m][n] = (f32x4){0.f, 0.f, 0.f, 0.f};
        cur = nxt; cA = nA; cB = nB; ++ui;
        if (wr == 1) PG8_BAR;
    }
    PG8_WAIT_V(0);
    PG8_BAR;
#undef PG8_SA
#undef PG8_SB
#undef PG8_STAGE
#undef PG8_LDA
#undef PG8_LDB
#undef PG8_MMA
#undef PG8_WAIT_V
#undef PG8_WAIT_L
#undef PG8_BAR
#undef PG8_SCHED
#undef PG8_UA
#undef PG8_UB
}
}
#define XB_TMO      128
#define XB_XCNT(j)  (256  + 64 * (j))
#define XB_XSUB(j)  (1280 + 64 * (j))
#define XB_XGEN(j)  (2304 + 64 * (j))
#define XB_TOP      3328
#define XB_TOPGEN   3392
#define XCD_BAR_WORDS 3456
#define XB_SPIN_CAP (1u << 18)

__device__ __forceinline__ unsigned xb_ld(unsigned* p)              { return __hip_atomic_load(p, __ATOMIC_RELAXED, __HIP_MEMORY_SCOPE_AGENT); }
__device__ __forceinline__ unsigned xb_add(unsigned* p, unsigned v) { return __hip_atomic_fetch_add(p, v, __ATOMIC_RELAXED, __HIP_MEMORY_SCOPE_AGENT); }
__device__ __forceinline__ unsigned xb_xcc_id() { return (unsigned)__builtin_amdgcn_s_getreg((3 << 11) | 20) & 0xFu; }
#define XB_SPIN(cond, bar) do { unsigned _sp = 0; while (cond) { __builtin_amdgcn_s_sleep(1); \
    if ((++_sp & 255u) == 0u) { if (xb_ld(&(bar)[XB_TMO])) break; if (_sp > XB_SPIN_CAP) { atomicAdd(&(bar)[XB_TMO], 1u); break; } } } } while (0)

struct XcdBarrier {
    unsigned* bar; unsigned x;
    volatile LAS unsigned* st;
};

__device__ __forceinline__ XcdBarrier xcd_barrier_post(unsigned* bar, volatile LAS unsigned* st) {
    XcdBarrier b; b.bar = bar; b.x = xb_xcc_id(); b.st = st;
    if (threadIdx.x == 0) (void)xb_add(&bar[XB_XCNT(b.x)], 1u);
    return b;
}
__device__ __forceinline__ void xcd_barrier_complete(unsigned* bar, unsigned x, unsigned& nloc, unsigned& nx) {
    const unsigned G = gridDim.x * gridDim.y * gridDim.z;
    unsigned sum, cnt, mine, sp = 0u;
    for (;;) {
        sum = 0u; cnt = 0u; mine = 0u;
#pragma unroll
        for (unsigned j = 0; j < 16; ++j) { const unsigned c = xb_ld(&bar[XB_XCNT(j)]); sum += c; cnt += (c > 0u) ? 1u : 0u; mine = (j == x) ? c : mine; }
        if (sum == G) break;
        __builtin_amdgcn_s_sleep(1);
        if ((++sp & 255u) == 0u) { if (xb_ld(&bar[XB_TMO])) break; if (sp > XB_SPIN_CAP) { atomicAdd(&bar[XB_TMO], 1u); break; } }
    }
    nloc = mine > 0u ? mine : 1u; nx = cnt > 0u ? cnt : 1u;
}

__device__ __forceinline__ void xcd_barrier(const XcdBarrier& b) {
    asm volatile("s_waitcnt vmcnt(0)" ::: "memory");
    __syncthreads();
    if (threadIdx.x == 0) {
        unsigned* bar = b.bar;
        __builtin_amdgcn_s_waitcnt(0);
        unsigned nloc = b.st[0], nx = b.st[1];
        if (nloc == 0u) { xcd_barrier_complete(bar, b.x, nloc, nx); b.st[0] = nloc; b.st[1] = nx; }
        const unsigned old = xb_add(&bar[XB_XSUB(b.x)], 1u);
        const unsigned gen = old / nloc;
        if (old + 1u == (gen + 1u) * nloc) {
            __builtin_amdgcn_fence(__ATOMIC_RELEASE, "agent");
            asm volatile("s_waitcnt vmcnt(0)" ::: "memory");
            const unsigned og = xb_add(&bar[XB_TOP], 1u);
            const unsigned tg = og / nx;
            if (og + 1u == (tg + 1u) * nx) xb_add(&bar[XB_TOPGEN], 1u);
            else XB_SPIN(xb_ld(&bar[XB_TOPGEN]) == tg, bar);
            __builtin_amdgcn_fence(__ATOMIC_ACQUIRE, "agent");
            xb_add(&bar[XB_XGEN(b.x)], 1u);
            asm volatile("s_waitcnt vmcnt(0)" ::: "memory");
        } else {
            XB_SPIN(xb_ld(&bar[XB_XGEN(b.x)]) == gen, bar);
            __builtin_amdgcn_fence(__ATOMIC_ACQUIRE, "agent");
            asm volatile("s_waitcnt vmcnt(0)" ::: "memory");
        }
    }
    __syncthreads();
}

constexpr int D = 2048, MCTX = 8192, MLAT = 16384, MTOK = 24576, DEPTH = 4, DFF = 8192;
constexpr int NPROJ = 4608;
constexpr int C_RQ = 0, C_RK = 512, C_RV = 1024, C_RG = 1536, C_LX = 2048, C_LG = 2560, C_AQ = 3072, C_AK = 3584, C_AV = 3840, C_SU = 4096;
constexpr int NCHUNK16 = MTOK / 16;
constexpr int NCHUNK128 = MTOK / 128;
constexpr float EPS = 1e-6f, LOG2E = 1.4426950408889634f;
enum { I_XP = 0, I_XS, I_CK, I_CV, I_SRET, I_SLRU, I_SSRE, I_SSIM, I_C, I_CCTX, I_WMOD, I_BMOD, I_NORM1, I_WIN, I_RDEC, I_RGN, I_LCW, I_LCB, I_LWA, I_LBA, I_LWX, I_LBX, I_LLAM,
       I_QN, I_KN, I_SINK, I_SARE, I_SAIM, I_SLDT, I_SBRE, I_SBIM, I_SCRE, I_SCIM, I_SD, I_SWGLU, I_SBGLU, I_WBR, I_WOUT, I_NORM2, I_WFF1, I_WFF2, N_IN };
constexpr size_t O_YP = 0, O_YS = 16777216, O_NK = 50331648, O_NV = 58720256, O_NRET = 67108864, O_NLRU = 83886080, O_NSRE = 84017152, O_NSIM = 84541440, O_END = 85065728;
constexpr size_t MiB = 1u << 20;
constexpr size_t WS_CTL = 0, CTL_ZERO_BYTES = 1 * MiB;
constexpr size_t WS_MOD = 1 * MiB;
constexpr size_t WS_A16 = 3 * MiB;
constexpr size_t WS_SSMK = 4 * MiB;
constexpr size_t WS_SSMC = 20 * MiB;
constexpr size_t WS_SSMB = 36 * MiB;
constexpr size_t WS_WGLU = 52 * MiB;
constexpr size_t WS_WLRU = 54 * MiB;
constexpr size_t WS_WIN1 = 62 * MiB;
constexpr size_t WS_WGATE = 134 * MiB;
constexpr size_t WS_WBR = 262 * MiB;
constexpr size_t WS_WOUT = 294 * MiB;
constexpr size_t WS_WFF1 = 326 * MiB;
constexpr size_t WS_WFF2 = 454 * MiB;
constexpr size_t WS_H = 582 * MiB;
constexpr size_t WS_PROJ = 678 * MiB;
constexpr size_t WS_O = 894 * MiB;
constexpr size_t WS_P = 990 * MiB;
constexpr size_t WS_MG = 1374 * MiB;
constexpr size_t WS_END = 1470 * MiB;
constexpr size_t WS_XC = WS_P;
constexpr size_t WS_LA = WS_XC + 24 * MiB;
constexpr size_t WS_LB = WS_LA + 48 * MiB;
constexpr size_t WS_HF = WS_LB + 48 * MiB;
constexpr size_t WS_YS = WS_HF + 48 * MiB;
constexpr size_t WS_BU = WS_YS + 24 * MiB;
constexpr size_t WS_HS = WS_BU + 48 * MiB;
constexpr size_t WS_KV = WS_HS + 24 * MiB;
constexpr size_t WS_SIN = WS_KV + 96 * MiB;
static_assert(WS_SIN + 48 * MiB <= WS_END, "mixer temporaries fit");
constexpr int CW_BAR = 4096;
constexpr int LDS_BYTES = 147456, LDS_MISC = 143360;

typedef const float* fptr_t;
typedef __attribute__((address_space(4))) const fptr_t* tab_t;
__device__ __forceinline__ tab_t in_tab() { tab_t t = (tab_t)__builtin_amdgcn_kernarg_segment_ptr(); asm volatile("" : "+s"(t)); return t; }
#define INP(i) (in_tab()[i])
__device__ __forceinline__ float bf2f(unsigned short b) { return __uint_as_float(((unsigned)b) << 16); }
__device__ __forceinline__ float bflo(unsigned w) { return __uint_as_float(w << 16); }
__device__ __forceinline__ float bfhi(unsigned w) { return __uint_as_float(w & 0xffff0000u); }
__device__ __forceinline__ unsigned pk2(float lo, float hi) { return pg8::cvt_pk_bf16(lo, hi); }
__device__ __forceinline__ bf16x8 pack8(const f32x4 a, const f32x4 b) { u32x4 w; w.x = pk2(a[0], a[1]); w.y = pk2(a[2], a[3]); w.z = pk2(b[0], b[1]); w.w = pk2(b[2], b[3]); return __builtin_bit_cast(bf16x8, w); }
__device__ __forceinline__ float sigmoidf_(float x) { return __builtin_amdgcn_rcpf(1.0f + __builtin_amdgcn_exp2f(-x * LOG2E)); }
__device__ __forceinline__ float siluf_(float x) { return x * sigmoidf_(x); }
__device__ __forceinline__ float gelu_tanh(float x) {
    const float u = 0.7978845608028654f * (x + 0.044715f * x * x * x); return x * sigmoidf_(2.0f * u); }
__device__ __forceinline__ f32x4 mfma16(bf16x8 a, bf16x8 b, f32x4 c) { return __builtin_amdgcn_mfma_f32_16x16x32_bf16(a, b, c, 0, 0, 0); }
__device__ __forceinline__ bf16x8 frag_tr(const LAS unsigned char* img, int ldb, int klo, int khi, int n0, int lane) {
    const int q = (lane & 15) >> 2, p = lane & 3;
    const s16x4 lo = __builtin_amdgcn_ds_read_tr16_b64_v4i16((LAS s16x4*)(img + (klo + q) * ldb + (n0 + 4 * p) * 2));
    const s16x4 hi = __builtin_amdgcn_ds_read_tr16_b64_v4i16((LAS s16x4*)(img + (khi + q) * ldb + (n0 + 4 * p) * 2));
    return __builtin_shufflevector(lo, hi, 0, 1, 2, 3, 4, 5, 6, 7);
}
template <int R> __device__ __forceinline__ void stage_rows(LAS unsigned char* img, int ldl, const bf16_t* src, size_t ldg, int tid) {
#pragma unroll
    for (int c = tid; c < R * 16; c += 512) { const int row = c >> 4, ch = c & 15; *(LAS u32x4*)(img + row * ldl + ch * 16) = *(const u32x4*)(src + (size_t)row * ldg + ch * 8); }
}
__device__ __forceinline__ int mod_row(int pm) { return pm < 32 ? 0 : 1 + ((pm - 32) >> 3); }

struct EpiStore {
    static constexpr bool PERM = true;
    bf16_t* O; int ldc; int relu2;
    __device__ __forceinline__ void operator()(const f32x4 (&acc)[2][2][4][2], const pg8::Unit& u, int wr, int wc, int fr, int fq) const {
        const int row0 = u.pm * 256 + wr * 64 + fr, col0 = u.pn * 256 + wc * 32 + 8 * fq;
#pragma unroll
        for (int ai = 0; ai < 2; ++ai)
#pragma unroll
            for (int m = 0; m < 4; ++m) { bf16_t* rowp = O + (size_t)(row0 + ai * 128 + m * 16) * ldc + col0;
#pragma unroll
                for (int bj = 0; bj < 2; ++bj) { f32x4 v0 = acc[ai][bj][m][0], v1 = acc[ai][bj][m][1];
                    if (relu2) {
#pragma unroll
                        for (int j = 0; j < 4; ++j) { const float a = fmaxf(v0[j], 0.f), b = fmaxf(v1[j], 0.f); v0[j] = a * a; v1[j] = b * b; } }
                    u32x4 w; w.x = pk2(v0[0], v0[1]); w.y = pk2(v0[2], v0[3]); w.z = pk2(v1[0], v1[1]); w.w = pk2(v1[2], v1[3]);
                    *(u32x4*)(rowp + bj * 128) = w; } }
    }
};
struct EpiResid {
    static constexpr bool PERM = false;
    float* X; const float* gmod;
    __device__ __forceinline__ void operator()(const f32x4 (&acc)[2][2][4][2], const pg8::Unit& u, int wr, int wc, int fr, int fq) const {
        const int row0 = u.pm * 256 + wr * 64 + fr, col0 = u.pn * 256 + wc * 32 + 4 * fq;
        const float* gp = gmod + (size_t)mod_row(u.pm) * 12288 + col0;
        f32x4 gv[2][2];
#pragma unroll
        for (int bj = 0; bj < 2; ++bj)
#pragma unroll
            for (int n = 0; n < 2; ++n) gv[bj][n] = *(const f32x4*)(gp + bj * 128 + n * 16);
#pragma unroll
        for (int ai = 0; ai < 2; ++ai)
#pragma unroll
            for (int m = 0; m < 4; ++m) { float* rowp = X + (size_t)(row0 + ai * 128 + m * 16) * D + col0;
#pragma unroll
                for (int bj = 0; bj < 2; ++bj)
#pragma unroll
                    for (int n = 0; n < 2; ++n) { f32x4* p = (f32x4*)(rowp + bj * 128 + n * 16); *p = *p + gv[bj][n] * acc[ai][bj][m][n]; } }
    }
};
struct EpiGate {
    static constexpr bool PERM = false;
    const bf16_t* P; bf16_t* MG;
    __device__ __forceinline__ void operator()(const f32x4 (&acc)[2][2][4][2], const pg8::Unit& u, int wr, int wc, int fr, int fq) const {
        const int row0 = u.pm * 256 + wr * 64 + fr, ch0 = u.pn * 64 + wc * 16 + 4 * fq;
#pragma unroll
        for (int ai = 0; ai < 2; ++ai)
#pragma unroll
            for (int m = 0; m < 4; ++m) { const size_t row = (size_t)(row0 + ai * 128 + m * 16);
                f32x4 s = (f32x4){0.f, 0.f, 0.f, 0.f};
#pragma unroll
                for (int b = 0; b < 4; ++b) { const u32x2 pw = *(const u32x2*)(P + row * 8192 + b * 2048 + ch0); const f32x4 a = acc[ai][b >> 1][m][b & 1];
                    s[0] += sigmoidf_(a[0]) * bflo(pw.x); s[1] += sigmoidf_(a[1]) * bfhi(pw.x); s[2] += sigmoidf_(a[2]) * bflo(pw.y); s[3] += sigmoidf_(a[3]) * bfhi(pw.y); }
                u32x2 w; w.x = pk2(s[0], s[1]); w.y = pk2(s[2], s[3]); *(u32x2*)(MG + row * D + ch0) = w; }
    }
};
struct EpiLru {
    static constexpr bool PERM = true;
    const bf16_t* XC; bf16_t* LA; bf16_t* LB; const float* ba; const float* bx; const float* lam;
    __device__ __forceinline__ void operator()(const f32x4 (&acc)[2][2][4][2], const pg8::Unit& u, int wr, int wc, int fr, int fq) const {
        const int row0 = u.pm * 256 + wr * 64 + fr, d = u.pn >> 2, ch0 = (u.pn & 3) * 128 + wc * 32 + 8 * fq;
        float bav[8], bxv[8], spv[8];
#pragma unroll
        for (int e = 0; e < 8; ++e) { bav[e] = ba[d * 512 + ch0 + e]; bxv[e] = bx[d * 512 + ch0 + e]; spv[e] = -8.0f * LOG2E * log1pf(__expf(-lam[d * 512 + ch0 + e])); }
#pragma unroll
        for (int ai = 0; ai < 2; ++ai)
#pragma unroll
            for (int m = 0; m < 4; ++m) { const size_t row = (size_t)(row0 + ai * 128 + m * 16);
                const u32x4 xw = *(const u32x4*)(XC + row * 512 + ch0);
                float xv[8] = {bflo(xw.x), bfhi(xw.x), bflo(xw.y), bfhi(xw.y), bflo(xw.z), bfhi(xw.z), bflo(xw.w), bfhi(xw.w)};
                float la[8], lb[8];
#pragma unroll
                for (int e = 0; e < 8; ++e) { const float r = sigmoidf_(acc[ai][0][m][e >> 2][e & 3] + bav[e]), ig = sigmoidf_(acc[ai][1][m][e >> 2][e & 3] + bxv[e]);
                    const float l2 = r * spv[e], a = __builtin_amdgcn_exp2f(l2); la[e] = l2; lb[e] = sqrtf(fmaxf(1.0f - a * a, 0.f)) * ig * xv[e]; }
                u32x4 w; w.x = pk2(la[0], la[1]); w.y = pk2(la[2], la[3]); w.z = pk2(la[4], la[5]); w.w = pk2(la[6], la[7]);
                *(u32x4*)(LA + row * 1024 + d * 512 + ch0) = w;
                w.x = pk2(lb[0], lb[1]); w.y = pk2(lb[2], lb[3]); w.z = pk2(lb[4], lb[5]); w.w = pk2(lb[6], lb[7]);
                *(u32x4*)(LB + row * 1024 + d * 512 + ch0) = w; }
    }
};
struct EpiGlu {
    static constexpr bool PERM = true;
    const bf16_t* YS; bf16_t* O; const float* bg;
    __device__ __forceinline__ void operator()(const f32x4 (&acc)[2][2][4][2], const pg8::Unit& u, int wr, int wc, int fr, int fq) const {
        const int row0 = u.pm * 256 + wr * 64 + fr, col0 = u.pn * 256 + wc * 32 + 8 * fq;
#pragma unroll
        for (int ai = 0; ai < 2; ++ai)
#pragma unroll
            for (int m = 0; m < 4; ++m) { const size_t row = (size_t)(row0 + ai * 128 + m * 16);
#pragma unroll
                for (int bj = 0; bj < 2; ++bj) { const int col = col0 + bj * 128;
                    const u32x4 yw = *(const u32x4*)(YS + row * 512 + col);
                    const float yv[8] = {bflo(yw.x), bfhi(yw.x), bflo(yw.y), bfhi(yw.y), bflo(yw.z), bfhi(yw.z), bflo(yw.w), bfhi(yw.w)};
                    float o[8];
#pragma unroll
                    for (int e = 0; e < 8; ++e) o[e] = yv[e] * sigmoidf_(acc[ai][bj][m][e >> 2][e & 3] + bg[col + e]);
                    u32x4 w; w.x = pk2(o[0], o[1]); w.y = pk2(o[2], o[3]); w.z = pk2(o[4], o[5]); w.w = pk2(o[6], o[7]);
                    *(u32x4*)(O + row * D + 1536 + col) = w; } }
    }
};

template <int MODE> __device__ __forceinline__ int src_col(int n_out, int coloff) {
    if (MODE == 0) return coloff + n_out;
    const int pn = n_out >> 8, c = n_out & 255, b = 2 * (c >> 7) + ((c >> 4) & 1), chl = 16 * ((c >> 5) & 3) + (c & 15);
    return coloff + b * 2048 + pn * 64 + chl;
}
template <int MODE> __device__ __forceinline__ void tr_item(const float* W, int ldsrc, int coloff, int K, bf16_t* WT, int row_off, int nblk, LAS float* scr, int item, int lane) {
    const int kb = item / nblk, nb = item % nblk, k0 = 64 * kb, n0 = 32 * nb;
    const int col = src_col<MODE>(n0 + (lane & 31), coloff);
#pragma unroll 8
    for (int i = 0; i < 32; ++i) { const int kk = 2 * i + (lane >> 5); scr[kk * 33 + (lane & 31)] = W[(size_t)(k0 + kk) * ldsrc + col]; }
    asm volatile("s_waitcnt lgkmcnt(0)" ::: "memory");
    const int c = lane & 7;
#pragma unroll
    for (int j = 0; j < 4; ++j) { const int n = (lane >> 3) + 8 * j; const LAS float* s = scr + (8 * c) * 33 + n;
        u32x4 o; o.x = pk2(s[0 * 33], s[1 * 33]); o.y = pk2(s[2 * 33], s[3 * 33]); o.z = pk2(s[4 * 33], s[5 * 33]); o.w = pk2(s[6 * 33], s[7 * 33]);
        *(u32x4*)(WT + (size_t)(row_off + n0 + n) * K + k0 + 8 * c) = o; }
    asm volatile("s_waitcnt lgkmcnt(0)" ::: "memory");
}
__device__ __forceinline__ void prologue_weights(tab_t in, unsigned char* ws, LAS unsigned char* lds, int gw, int NGW, int wave, int lane) {
    LAS float* scr = (LAS float*)(lds + wave * 16384);
    constexpr int I1 = 32 * 144, I2 = 32 * 256, I3 = 8 * 64, I4 = 32 * 64, I5 = 32 * 256, I6 = 128 * 64, I7 = 8 * 16;
    constexpr int PER = I1 + I2 + 4 * I3 + I4 + I5 + I6 + I7;
    for (int it = gw; it < DEPTH * PER; it += NGW) {
        const int l = it / PER; int r = it % PER;
        if (r < I1) { tr_item<0>(in[I_WIN] + (size_t)l * 2048 * 12800, 12800, 0, 2048, (bf16_t*)(ws + WS_WIN1) + (size_t)l * 4608 * 2048, 0, 144, scr, r, lane); continue; } r -= I1;
        if (r < I2) { tr_item<1>(in[I_WIN] + (size_t)l * 2048 * 12800, 12800, 4608, 2048, (bf16_t*)(ws + WS_WGATE) + (size_t)l * 8192 * 2048, 0, 256, scr, r, lane); continue; } r -= I2;
        if (r < 4 * I3) { const int b = r / I3; tr_item<0>(in[I_WBR] + (size_t)(l * 4 + b) * 512 * 2048, 2048, 0, 512, (bf16_t*)(ws + WS_WBR) + (size_t)l * 8192 * 512, b * 2048, 64, scr, r % I3, lane); continue; } r -= 4 * I3;
        if (r < I4) { tr_item<0>(in[I_WOUT] + (size_t)l * 2048 * 2048, 2048, 0, 2048, (bf16_t*)(ws + WS_WOUT) + (size_t)l * 2048 * 2048, 0, 64, scr, r, lane); continue; } r -= I4;
        if (r < I5) { tr_item<0>(in[I_WFF1] + (size_t)l * 2048 * 8192, 8192, 0, 2048, (bf16_t*)(ws + WS_WFF1) + (size_t)l * 8192 * 2048, 0, 256, scr, r, lane); continue; } r -= I5;
        if (r < I6) { tr_item<0>(in[I_WFF2] + (size_t)l * 8192 * 2048, 2048, 0, 8192, (bf16_t*)(ws + WS_WFF2) + (size_t)l * 2048 * 8192, 0, 64, scr, r, lane); continue; } r -= I6;
        tr_item<0>(in[I_SWGLU] + (size_t)l * 512 * 512, 512, 0, 512, (bf16_t*)(ws + WS_WGLU) + (size_t)l * 512 * 512, 0, 16, scr, r, lane);
    }
}
__device__ __forceinline__ void prologue_lru_w(tab_t in, unsigned char* ws, int gtid, int NT) {
    bf16_t* WL = (bf16_t*)(ws + WS_WLRU);
    for (int idx = gtid; idx < DEPTH * 2048 * 64; idx += NT) {
        const int kc = idx & 63, rr = (idx >> 6) & 2047, l = idx >> 17;
        const int pn = rr >> 8, d = pn >> 2, nb = pn & 3, c = rr & 255, gate = c >> 7, cc = c & 127;
        u32x4 o = (u32x4){0u, 0u, 0u, 0u};
        if ((kc >> 4) == nb) { const float* src = (gate ? in[I_LWX] : in[I_LWA]) + ((size_t)((l * 2 + d) * 4 + nb) * 128 + (kc & 15) * 8) * 128 + cc;
            o.x = pk2(src[0], src[128]); o.y = pk2(src[256], src[384]); o.z = pk2(src[512], src[640]); o.w = pk2(src[768], src[896]); }
        *(u32x4*)(WL + ((size_t)l * 2048 + rr) * 512 + kc * 8) = o;
    }
}
__device__ __forceinline__ void prologue_mod(tab_t in, unsigned char* ws, LAS unsigned char* lds, int bid, int G, int tid, int wave, int lane) {
    LAS float* sc = (LAS float*)lds;
    LAS float* red = (LAS float*)(lds + 73728);
    for (int i = tid; i < 9 * 2048; i += 512) { const int r = i >> 11, k = i & 2047; const float v = r == 0 ? in[I_CCTX][k] : in[I_C][(r - 1) * 2048 + k]; sc[i] = siluf_(v); }
    __syncthreads();
    float* MOD = (float*)(ws + WS_MOD);
    for (int it = bid; it < DEPTH * 192; it += G) {
        const int l = it / 192, cb = it % 192, col = cb * 64 + lane, kbase = wave * 256;
        const float* w = in[I_WMOD] + ((size_t)l * 2048 + kbase) * 12288 + col;
        float acc[9];
#pragma unroll
        for (int r = 0; r < 9; ++r) acc[r] = 0.f;
        for (int k = 0; k < 256; k += 4) {
            const float w0 = w[(size_t)k * 12288], w1 = w[(size_t)(k + 1) * 12288], w2 = w[(size_t)(k + 2) * 12288], w3 = w[(size_t)(k + 3) * 12288];
#pragma unroll
            for (int r = 0; r < 9; ++r) { const f32x4 s4 = *(const LAS f32x4*)(sc + r * 2048 + kbase + k); acc[r] += s4[0] * w0 + s4[1] * w1 + s4[2] * w2 + s4[3] * w3; }
        }
#pragma unroll
        for (int r = 0; r < 9; ++r) red[(wave * 9 + r) * 64 + lane] = acc[r];
        __syncthreads();
        for (int i = tid; i < 576; i += 512) { const int r = i >> 6, cl = i & 63; float s = in[I_BMOD][l * 12288 + cb * 64 + cl];
#pragma unroll
            for (int w8 = 0; w8 < 8; ++w8) s += red[(w8 * 9 + r) * 64 + cl];
            MOD[(size_t)(l * 9 + r) * 12288 + cb * 64 + cl] = s; }
        __syncthreads();
    }
}
__device__ __forceinline__ void cpow(float are, float aim, float dt, float tau, float& re, float& im) {
    const float mag = __expf(are * dt * tau); float rev = aim * dt * tau * 0.15915494309189535f; rev -= rintf(rev);
    re = mag * __builtin_amdgcn_cosf(rev); im = mag * __builtin_amdgcn_sinf(rev);
}
__device__ __forceinline__ void prologue_ssm(tab_t in, unsigned char* ws, LAS unsigned char* lds, int bid, int G, int tid) {
    LAS float* pw = (LAS float*)lds;
    LAS float* bb = pw + 2 * 17 * 64 * 2;
    LAS float* cc = bb + 2 * 64 * 16 * 2;
    LAS float* kf = cc + 2 * 16 * 64 * 2;
    LAS float* cf = kf + 2 * 16 * 256;
    for (int un = bid; un < DEPTH * 32; un += G) {
        const int l = un >> 5, g = un & 31;
        __syncthreads();
        if (tid < 128) { const int d = tid >> 6, p = tid & 63; const int ix = ((l * 2 + d) * 32 + g) * 64 + p;
            const float are = in[I_SARE][ix], aim = in[I_SAIM][ix], dt = __expf(in[I_SLDT][(l * 2 + d) * 32 + g]);
            for (int tau = 0; tau <= 16; ++tau) { float re, im; cpow(are, aim, dt, (float)tau, re, im); pw[((d * 17 + tau) * 64 + p) * 2] = re; pw[((d * 17 + tau) * 64 + p) * 2 + 1] = im;
                if (tau == 16) { float* A16 = (float*)(ws + WS_A16); A16[ix * 2] = re; A16[ix * 2 + 1] = im; }
                if (tau == 1) { const float zr = re - 1.0f, zi = im, den = 1.0f / (are * are + aim * aim); cf[(d * 64 + p) * 2] = (zr * are + zi * aim) * den; cf[(d * 64 + p) * 2 + 1] = (zi * are - zr * aim) * den; } }
        }
        __syncthreads();
        for (int i = tid; i < 2048; i += 512) { const int d = i >> 10, p = (i >> 4) & 63, c = i & 15;
            const size_t bix = ((size_t)((l * 2 + d) * 32 + g) * 64 + p) * 16 + c; const float br = in[I_SBRE][bix], bi = in[I_SBIM][bix], fr = cf[(d * 64 + p) * 2], fi = cf[(d * 64 + p) * 2 + 1];
            bb[i * 2] = fr * br - fi * bi; bb[i * 2 + 1] = fr * bi + fi * br;
            const int c2 = (i >> 6) & 15, p2 = i & 63; const size_t cix = ((size_t)((l * 2 + d) * 32 + g) * 16 + c2) * 64 + p2;
            cc[i * 2] = in[I_SCRE][cix]; cc[i * 2 + 1] = in[I_SCIM][cix]; }
        __syncthreads();
        for (int i = tid; i < 8192; i += 512) { const int d = i >> 12, tau = (i >> 8) & 15, c = (i >> 4) & 15, c2 = i & 15; float s = 0.f;
            for (int p = 0; p < 64; ++p) { const float cr = cc[((d * 16 + c) * 64 + p) * 2], ci = cc[((d * 16 + c) * 64 + p) * 2 + 1], ar = pw[((d * 17 + tau) * 64 + p) * 2], ai = pw[((d * 17 + tau) * 64 + p) * 2 + 1];
                const float wr = cr * ar - ci * ai, wi = cr * ai + ci * ar; s += wr * bb[((d * 64 + p) * 16 + c2) * 2] - wi * bb[((d * 64 + p) * 16 + c2) * 2 + 1]; }
            kf[i] = s; }
        __syncthreads();
        bf16_t* KM = (bf16_t*)(ws + WS_SSMK) + (size_t)(l * 32 + g) * 65536;
        bf16_t* CM = (bf16_t*)(ws + WS_SSMC) + (size_t)(l * 32 + g) * 65536;
        bf16_t* BMp = (bf16_t*)(ws + WS_SSMB) + (size_t)(l * 32 + g) * 65536;
        for (int i = tid; i < 32768; i += 512) {
            const int row = i >> 7, col = (i & 127) * 2;
            float v[2], w[2], z[2];
#pragma unroll
            for (int e = 0; e < 2; ++e) { const int cl = col + e;
                { const int t = row >> 4, c = row & 15, s = cl >> 4, c2 = cl & 15; float x = 0.f;
                  if (s <= t) x += kf[(0 * 16 + (t - s)) * 256 + c * 16 + c2];
                  if (s >= t) x += kf[(1 * 16 + (s - t)) * 256 + c * 16 + c2];
                  if (s == t && c == c2) x += in[I_SD][l * 512 + g * 16 + c];
                  v[e] = x; }
                { const int t = row >> 4, c = row & 15, d = cl >> 7, im = (cl >> 6) & 1, p = cl & 63, tau = d == 0 ? t + 1 : 16 - t;
                  const float cr = cc[((d * 16 + c) * 64 + p) * 2], ci = cc[((d * 16 + c) * 64 + p) * 2 + 1], ar = pw[((d * 17 + tau) * 64 + p) * 2], ai = pw[((d * 17 + tau) * 64 + p) * 2 + 1];
                  w[e] = im ? -(cr * ai + ci * ar) : (cr * ar - ci * ai); }
                { const int d = row >> 7, im = (row >> 6) & 1, p = row & 63, s = cl >> 4, c2 = cl & 15, tau = d == 0 ? 15 - s : s;
                  const float ar = pw[((d * 17 + tau) * 64 + p) * 2], ai = pw[((d * 17 + tau) * 64 + p) * 2 + 1], br = bb[((d * 64 + p) * 16 + c2) * 2], bi = bb[((d * 64 + p) * 16 + c2) * 2 + 1];
                  z[e] = im ? (ar * bi + ai * br) : (ar * br - ai * bi); } }
            *(unsigned*)(KM + (size_t)row * 256 + col) = pk2(v[0], v[1]);
            *(unsigned*)(CM + (size_t)row * 256 + col) = pk2(w[0], w[1]);
            *(unsigned*)(BMp + (size_t)row * 256 + col) = pk2(z[0], z[1]);
        }
    }
    __syncthreads();
}
__device__ __forceinline__ void norm_phase(const float* xp, const float* xs, float* X, bool first, const float* gain, const float* modl, int sh_idx, int sc_idx, bf16_t* H, int gw, int NGW, int lane) {
    for (int row = gw; row < MTOK; row += NGW) {
        const float* src = first ? (row < MCTX ? xp + (size_t)row * D : xs + (size_t)(row - MCTX) * D) : X + (size_t)row * D;
        f32x4 v[8]; float ss = 0.f;
#pragma unroll
        for (int j = 0; j < 8; ++j) { v[j] = *(const f32x4*)(src + 4 * (lane + 64 * j)); ss += (v[j][0] * v[j][0] + v[j][1] * v[j][1]) + (v[j][2] * v[j][2] + v[j][3] * v[j][3]); }
#pragma unroll
        for (int o = 1; o < 64; o <<= 1) ss += __shfl_xor(ss, o);
        const float rstd = rsqrtf(ss * (1.0f / D) + EPS);
        const int r = row < MCTX ? 0 : 1 + ((row - MCTX) >> 11);
        const float* mp = modl + (size_t)r * 12288;
#pragma unroll
        for (int j = 0; j < 8; ++j) { const int col = 4 * (lane + 64 * j);
            const f32x4 g4 = *(const f32x4*)(gain + col), sc4 = *(const f32x4*)(mp + sc_idx * 2048 + col), sh4 = *(const f32x4*)(mp + sh_idx * 2048 + col);
            const f32x4 y = v[j] * rstd * g4 * (sc4 + 1.0f) + sh4;
            u32x2 w; w.x = pk2(y[0], y[1]); w.y = pk2(y[2], y[3]); *(u32x2*)(H + (size_t)row * D + col) = w;
            if (first) *(f32x4*)(X + (size_t)row * D + col) = v[j]; }
    }
}

__device__ __forceinline__ void m1_attn_prep(bf16_t* PROJ, const float* qn, const float* kn, float* out, int l, int gtid, int NT) {
    for (int idx = gtid; idx < MTOK * 128; idx += NT) {
        const int part = idx & 15, hs = (idx >> 4) & 7, row = idx >> 7; const bool ctx = row < MCTX;
        if (hs >= 6 && !ctx) continue;
        const int col = (hs < 4 ? C_AQ + hs * 128 : hs < 6 ? C_AK + (hs - 4) * 128 : C_AV + (hs - 6) * 128) + part * 8;
        bf16_t* p = PROJ + (size_t)row * NPROJ + col;
        const u32x4 w = *(const u32x4*)p;
        float x[8] = {bflo(w.x), bfhi(w.x), bflo(w.y), bfhi(w.y), bflo(w.z), bfhi(w.z), bflo(w.w), bfhi(w.w)};
        if (hs >= 6) { float* o = out + O_NV + ((size_t)((row >> 8) * 4 + l) * 256 + (row & 255)) * 256 + (hs - 6) * 128 + part * 8;
            *(f32x4*)o = (f32x4){x[0], x[1], x[2], x[3]}; *(f32x4*)(o + 4) = (f32x4){x[4], x[5], x[6], x[7]}; continue; }
        float ss = 0.f;
#pragma unroll
        for (int e = 0; e < 8; ++e) ss += x[e] * x[e];
        ss += __shfl_xor(ss, 1); ss += __shfl_xor(ss, 2); ss += __shfl_xor(ss, 4); ss += __shfl_xor(ss, 8);
        const float rstd = rsqrtf(ss * (1.0f / 128.0f) + EPS);
        const float* gn = (hs < 4 ? qn : kn) + part * 8;
#pragma unroll
        for (int e = 0; e < 8; ++e) x[e] = x[e] * rstd * gn[e];
        if (ctx) { if (hs >= 4) { float* o = out + O_NK + ((size_t)((row >> 8) * 4 + l) * 256 + (row & 255)) * 256 + (hs - 4) * 128 + part * 8;
                *(f32x4*)o = (f32x4){x[0], x[1], x[2], x[3]}; *(f32x4*)(o + 4) = (f32x4){x[4], x[5], x[6], x[7]}; } }
        else { const int t = (row - MCTX) & 2047; const float rp = (float)(t >> 6), cp = (float)(t & 63);
#pragma unroll
            for (int e = 0; e < 8; ++e) { const float other = __shfl_xor(x[e], 8); const int i = (part & 7) * 8 + e; const float pos = i < 32 ? rp : cp;
                float rev = pos * __builtin_amdgcn_exp2f(-(float)(i & 31) * 0.41524101186092029f) * 0.15915494309189535f; rev -= rintf(rev);
                const float cs = __builtin_amdgcn_cosf(rev), sn = __builtin_amdgcn_sinf(rev);
                x[e] = part < 8 ? x[e] * cs - other * sn : x[e] * cs + other * sn; } }
        u32x4 o; o.x = pk2(x[0], x[1]); o.y = pk2(x[2], x[3]); o.z = pk2(x[4], x[5]); o.w = pk2(x[6], x[7]);
        *(u32x4*)p = o;
    }
}
__device__ __forceinline__ void m1_lru_conv(const bf16_t* PROJ, bf16_t* XC, const float* cw, const float* cb, int gtid, int NT) {
    for (int idx = gtid; idx < MTOK * 64; idx += NT) {
        const int row = idx >> 6, c8 = (idx & 63) * 8;
        const int t = row < MCTX ? (row & 255) : ((row - MCTX) & 2047), L = row < MCTX ? 256 : 2048;
        float a[8];
#pragma unroll
        for (int e = 0; e < 8; ++e) a[e] = cb[c8 + e];
#pragma unroll
        for (int j = 0; j < 4; ++j) { const int tt = t - 2 + j;
            if (tt >= 0 && tt < L) { const u32x4 w = *(const u32x4*)(PROJ + (size_t)(row - 2 + j) * NPROJ + C_LX + c8);
                const float x[8] = {bflo(w.x), bfhi(w.x), bflo(w.y), bfhi(w.y), bflo(w.z), bfhi(w.z), bflo(w.w), bfhi(w.w)};
#pragma unroll
                for (int e = 0; e < 8; ++e) a[e] += cw[j * 512 + c8 + e] * x[e]; } }
        u32x4 o; o.x = pk2(a[0], a[1]); o.y = pk2(a[2], a[3]); o.z = pk2(a[4], a[5]); o.w = pk2(a[6], a[7]);
        *(u32x4*)(XC + (size_t)row * 512 + c8) = o;
    }
}
__device__ __forceinline__ void m1_ssm_bu(const bf16_t* PROJ, const bf16_t* BMl, float* BU, int unit, int wave, int lane) {
    const int g = unit >> 3, bt0 = (unit & 7) * 12, fr = lane & 15, G4 = lane >> 4;
    const bf16_t* BMg = BMl + (size_t)g * 65536;
    bf16x8 af[2][8];
#pragma unroll
    for (int qi = 0; qi < 2; ++qi)
#pragma unroll
        for (int ks = 0; ks < 8; ++ks) af[qi][ks] = *(const bf16x8*)(BMg + (size_t)((2 * wave + qi) * 16 + fr) * 256 + ks * 32 + G4 * 8);
    for (int bt = bt0; bt < bt0 + 12; ++bt) {
        const int chunk = bt * 16 + fr;
        const bf16_t* up = PROJ + (size_t)(chunk * 16 + (G4 >> 1)) * NPROJ + C_SU + 16 * g + 8 * (G4 & 1);
        f32x4 acc[2] = {(f32x4){0.f, 0.f, 0.f, 0.f}, (f32x4){0.f, 0.f, 0.f, 0.f}};
#pragma unroll
        for (int ks = 0; ks < 8; ++ks) { const bf16x8 b = *(const bf16x8*)(up + (size_t)(2 * ks) * NPROJ);
            acc[0] = mfma16(af[0][ks], b, acc[0]); acc[1] = mfma16(af[1][ks], b, acc[1]); }
#pragma unroll
        for (int qi = 0; qi < 2; ++qi) *(f32x4*)(BU + ((size_t)g * NCHUNK16 + chunk) * 256 + (2 * wave + qi) * 16 + 4 * G4) = acc[qi];
    }
}
__device__ __forceinline__ float ret_log2gamma(float logit) { return -log1pf(__expf(-logit)) * LOG2E; }
__device__ __forceinline__ void m1_ret_kv(const bf16_t* PROJ, float* KV, const float* decl, LAS unsigned char* lds, int unit, int tid, int wave, int lane) {
    const int cn = unit >> 2, hh = unit & 3, fr = lane & 15, G4 = lane >> 4;
    LAS unsigned char* Ks = lds; LAS unsigned char* Vf = lds + 128 * 288; LAS unsigned char* Vb = lds + 2 * 128 * 288;
    const float lgf = ret_log2gamma(decl[hh]), lgb = ret_log2gamma(decl[4 + hh]);
    const size_t row0 = (size_t)cn * 128;
    __syncthreads();
    stage_rows<128>(Ks, 288, PROJ + row0 * NPROJ + C_RK + hh * 128, NPROJ, tid);
#pragma unroll
    for (int c = tid; c < 128 * 16; c += 512) { const int j = c >> 4, ch = c & 15; const u32x4 w = *(const u32x4*)(PROJ + (row0 + j) * NPROJ + C_RV + hh * 128 + ch * 8);
        const float wf = __builtin_amdgcn_exp2f((float)(127 - j) * lgf), wb = __builtin_amdgcn_exp2f((float)j * lgb);
        const float x[8] = {bflo(w.x), bfhi(w.x), bflo(w.y), bfhi(w.y), bflo(w.z), bfhi(w.z), bflo(w.w), bfhi(w.w)};
        u32x4 o; o.x = pk2(x[0] * wf, x[1] * wf); o.y = pk2(x[2] * wf, x[3] * wf); o.z = pk2(x[4] * wf, x[5] * wf); o.w = pk2(x[6] * wf, x[7] * wf);
        *(LAS u32x4*)(Vf + j * 288 + ch * 16) = o;
        o.x = pk2(x[0] * wb, x[1] * wb); o.y = pk2(x[2] * wb, x[3] * wb); o.z = pk2(x[4] * wb, x[5] * wb); o.w = pk2(x[6] * wb, x[7] * wb);
        *(LAS u32x4*)(Vb + j * 288 + ch * 16) = o; }
    __syncthreads();
    f32x4 af[8], ab[8];
#pragma unroll
    for (int nt = 0; nt < 8; ++nt) { af[nt] = (f32x4){0.f, 0.f, 0.f, 0.f}; ab[nt] = (f32x4){0.f, 0.f, 0.f, 0.f}; }
#pragma unroll
    for (int ks = 0; ks < 4; ++ks) {
        const bf16x8 a = frag_tr(Ks, 288, 32 * ks + 8 * G4, 32 * ks + 8 * G4 + 4, 16 * wave, lane);
#pragma unroll
        for (int nt = 0; nt < 8; ++nt) { const bf16x8 bf = frag_tr(Vf, 288, 32 * ks + 8 * G4, 32 * ks + 8 * G4 + 4, 16 * nt, lane), bb = frag_tr(Vb, 288, 32 * ks + 8 * G4, 32 * ks + 8 * G4 + 4, 16 * nt, lane);
            af[nt] = mfma16(a, bf, af[nt]); ab[nt] = mfma16(a, bb, ab[nt]); }
    }
    float* base = KV + (size_t)((cn * 4 + hh) * 2) * 16384;
#pragma unroll
    for (int nt = 0; nt < 8; ++nt) { *(f32x4*)(base + (size_t)(16 * nt + fr) * 128 + 16 * wave + 4 * G4) = af[nt]; *(f32x4*)(base + 16384 + (size_t)(16 * nt + fr) * 128 + 16 * wave + 4 * G4) = ab[nt]; }
}

__device__ __forceinline__ void m2_attn_unit(const bf16_t* PROJ, const float* ck, const float* cv, bf16_t* O, const float* sink, LAS unsigned char* lds, int u, int l, int tid, int wave, int lane) {
    const int fr = lane & 15, G4 = lane >> 4;
    const bool lat = u >= 256; int seq, kvh, qb; size_t rbase;
    if (!lat) { seq = u >> 3; kvh = (u >> 2) & 1; qb = u & 3; rbase = (size_t)seq * 256; }
    else { const int v = u - 256; seq = v >> 6; kvh = (v >> 5) & 1; qb = v & 31; rbase = (size_t)MCTX + (size_t)seq * 2048; }
    const int head = 2 * kvh + (wave >> 2), qq = (wave & 3) * 16 + fr;
    LAS unsigned char* Ks = lds; LAS unsigned char* Vs = lds + 64 * 272;
    bf16x8 qf[4];
    { const bf16_t* qp = PROJ + (rbase + qb * 64 + qq) * NPROJ + C_AQ + head * 128 + G4 * 8;
#pragma unroll
      for (int ks = 0; ks < 4; ++ks) qf[ks] = *(const bf16x8*)(qp + ks * 32); }
    float mrun = sink[head] * LOG2E, lsum = G4 == 0 ? 1.0f : 0.0f;
    f32x4 oacc[8];
#pragma unroll
    for (int mt = 0; mt < 8; ++mt) oacc[mt] = (f32x4){0.f, 0.f, 0.f, 0.f};
    const float SC2 = 0.08838834764831845f * LOG2E;
    const int ntile = lat ? 9 : 4;
    for (int it = 0; it < ntile; ++it) {
        int kind = 0, mask = 0; size_t krow0 = 0; int p0 = 0;
        if (!lat) krow0 = rbase + 64 * it;
        else if (it < 5) { const int tb = qb - 2 + it; if (tb < 0 || tb >= 32) continue; krow0 = rbase + 64 * tb; mask = it == 0 ? 1 : it == 4 ? 2 : 0; }
        else { kind = 1; p0 = 64 * (it - 5); }
        __syncthreads();
        if (kind == 0) { stage_rows<64>(Ks, 272, PROJ + krow0 * NPROJ + C_AK + kvh * 128, NPROJ, tid); stage_rows<64>(Vs, 288, PROJ + krow0 * NPROJ + C_AV + kvh * 128, NPROJ, tid); }
        else {
#pragma unroll
            for (int c = tid; c < 64 * 16; c += 512) { const int j = c >> 4, ch = c & 15; const size_t off = ((size_t)((seq * 4 + l) * 256 + p0 + j)) * 256 + kvh * 128 + ch * 8;
                const f32x4 k0 = *(const f32x4*)(ck + off), k1 = *(const f32x4*)(ck + off + 4), v0 = *(const f32x4*)(cv + off), v1 = *(const f32x4*)(cv + off + 4);
                u32x4 o; o.x = pk2(k0[0], k0[1]); o.y = pk2(k0[2], k0[3]); o.z = pk2(k1[0], k1[1]); o.w = pk2(k1[2], k1[3]); *(LAS u32x4*)(Ks + j * 272 + ch * 16) = o;
                o.x = pk2(v0[0], v0[1]); o.y = pk2(v0[2], v0[3]); o.z = pk2(v1[0], v1[1]); o.w = pk2(v1[2], v1[3]); *(LAS u32x4*)(Vs + j * 288 + ch * 16) = o; } }
        __syncthreads();
        f32x4 sa[4];
#pragma unroll
        for (int nt = 0; nt < 4; ++nt) { sa[nt] = (f32x4){0.f, 0.f, 0.f, 0.f};
#pragma unroll
            for (int ks = 0; ks < 4; ++ks) sa[nt] = mfma16(*(const LAS bf16x8*)(Ks + (nt * 16 + fr) * 272 + (ks * 32 + G4 * 8) * 2), qf[ks], sa[nt]); }
        float tmax = -3.0e38f;
#pragma unroll
        for (int nt = 0; nt < 4; ++nt)
#pragma unroll
            for (int r = 0; r < 4; ++r) { const int jj = 16 * nt + 4 * G4 + r; float s = sa[nt][r] * SC2;
                if (mask == 1 && jj < qq) s = -3.0e38f; if (mask == 2 && jj > qq) s = -3.0e38f; sa[nt][r] = s; tmax = fmaxf(tmax, s); }
        tmax = fmaxf(tmax, __shfl_xor(tmax, 16)); tmax = fmaxf(tmax, __shfl_xor(tmax, 32));
        const float mnew = fmaxf(mrun, tmax), alpha = __builtin_amdgcn_exp2f(mrun - mnew); mrun = mnew;
        float ps = 0.f;
#pragma unroll
        for (int nt = 0; nt < 4; ++nt)
#pragma unroll
            for (int r = 0; r < 4; ++r) { const float p = __builtin_amdgcn_exp2f(sa[nt][r] - mnew); sa[nt][r] = p; ps += p; }
        lsum = lsum * alpha + ps;
        const bf16x8 pf0 = pack8(sa[0], sa[1]), pf1 = pack8(sa[2], sa[3]);
#pragma unroll
        for (int mt = 0; mt < 8; ++mt) { oacc[mt] = oacc[mt] * alpha;
            oacc[mt] = mfma16(frag_tr(Vs, 288, 4 * G4, 16 + 4 * G4, 16 * mt, lane), pf0, oacc[mt]);
            oacc[mt] = mfma16(frag_tr(Vs, 288, 32 + 4 * G4, 48 + 4 * G4, 16 * mt, lane), pf1, oacc[mt]); }
    }
    lsum += __shfl_xor(lsum, 16); lsum += __shfl_xor(lsum, 32);
    const float inv = 1.0f / lsum;
    bf16_t* op = O + (rbase + qb * 64 + qq) * D + 1024 + head * 128 + 4 * G4;
#pragma unroll
    for (int mt = 0; mt < 8; ++mt) { u32x2 w; w.x = pk2(oacc[mt][0] * inv, oacc[mt][1] * inv); w.y = pk2(oacc[mt][2] * inv, oacc[mt][3] * inv); *(u32x2*)(op + 16 * mt) = w; }
}
__device__ __forceinline__ void m2_ssm_scan(const float* BU, bf16_t* HS, const float* A16l, const float* sre, const float* sim, float* out, int l, int item, int tid) {
    const int seq = item >> 3, g = (item & 7) * 4 + (tid >> 7), c = tid & 127, dir = c >> 6, p = c & 63;
    const bool lat = seq >= 32; const int chunk0 = lat ? 512 + (seq - 32) * 128 : seq * 16, N = lat ? 128 : 16;
    const float ar = A16l[((dir * 32 + g) * 64 + p) * 2], ai = A16l[((dir * 32 + g) * 64 + p) * 2 + 1];
    float hr = 0.f, hi = 0.f;
    if (lat) { const size_t ix = ((size_t)(((seq - 32) * 4 + l) * 2 + dir) * 32 + g) * 64 + p; hr = sre[ix]; hi = sim[ix]; }
    for (int st = 0; st < N; ++st) { const int chunk = chunk0 + (dir == 0 ? st : N - 1 - st);
        bf16_t* hp = HS + ((size_t)chunk * 32 + g) * 256 + dir * 128 + p; hp[0] = (bf16_t)(pk2(hr, 0.f) & 0xffffu); hp[64] = (bf16_t)(pk2(hi, 0.f) & 0xffffu);
        const float* bp = BU + ((size_t)g * NCHUNK16 + chunk) * 256 + dir * 128 + p; const float br = bp[0], bi = bp[64];
        const float nr = ar * hr - ai * hi + br, ni = ar * hi + ai * hr + bi; hr = nr; hi = ni; }
    if (!lat) { const size_t ix = ((size_t)((seq * 4 + l) * 2 + dir) * 32 + g) * 64 + p; out[O_NSRE + ix] = hr; out[O_NSIM + ix] = hi; }
}
__device__ __forceinline__ void m2_ret_scan(const float* KV, bf16_t* SIN, const float* sret, const float* decl, float* out, int l, int gtid, int NT) {
    for (int idx = gtid; idx < 40 * 4 * 2 * 128 * 32; idx += NT) {
        const int dk4 = (idx & 31) * 4, dv = (idx >> 5) & 127, dir = (idx >> 12) & 1, hh = (idx >> 13) & 3, seq = idx >> 15;
        const bool lat = seq >= 32; const int c0 = lat ? 64 + (seq - 32) * 16 : seq * 2, N = lat ? 16 : 2;
        const float g128 = __builtin_amdgcn_exp2f(128.0f * ret_log2gamma(decl[dir * 4 + hh]));
        f32x4 S = (f32x4){0.f, 0.f, 0.f, 0.f};
        if (lat) { const float* sp = sret + ((size_t)((((seq - 32) * 4 + l) * 2 + dir) * 4 + hh) * 128 + dk4) * 128 + dv; S = (f32x4){sp[0], sp[128], sp[256], sp[384]}; }
        for (int st = 0; st < N; ++st) { const int cn = c0 + (dir == 0 ? st : N - 1 - st); const size_t off = (size_t)((cn * 4 + hh) * 2 + dir) * 16384 + (size_t)dv * 128 + dk4;
            u32x2 w; w.x = pk2(S[0], S[1]); w.y = pk2(S[2], S[3]); *(u32x2*)(SIN + off) = w;
            S = S * g128 + *(const f32x4*)(KV + off); }
        if (!lat) { float* op = out + O_NRET + ((size_t)(((seq * 4 + l) * 2 + dir) * 4 + hh) * 128 + dk4) * 128 + dv; op[0] = S[0]; op[128] = S[1]; op[256] = S[2]; op[384] = S[3]; }
    }
}

__device__ __forceinline__ void m3_lru_scan(const bf16_t* LA, const bf16_t* LB, float* HF, const bf16_t* PROJ, bf16_t* O, const float* slru, float* out, LAS unsigned char* lds, int l, int task, int wave, int lane) {
    const bool lat = task >= 256; const int seq = lat ? 32 + ((task - 256) >> 3) : task >> 3, cg = task & 7;
    const size_t rbase = lat ? (size_t)MCTX + (size_t)(seq - 32) * 2048 : (size_t)seq * 256; const int T = lat ? 256 : 32;
    const int ch = cg * 64 + lane, seg = wave;
    LAS float* sA = (LAS float*)lds;
    LAS float* sH = sA + 1024;
    float As = 0.f, hf = 0.f, Ab = 0.f, hb = 0.f;
    { const bf16_t* pa = LA + (rbase + (size_t)seg * T) * 1024 + ch; const bf16_t* pb = LB + (rbase + (size_t)seg * T) * 1024 + ch;
#pragma unroll 8
      for (int t = 0; t < T; ++t) { const float la = bf2f(pa[(size_t)t * 1024]), lb = bf2f(pb[(size_t)t * 1024]); hf = __builtin_amdgcn_exp2f(la) * hf + lb; As += la; }
#pragma unroll 8
      for (int t = T - 1; t >= 0; --t) { const float la = bf2f(pa[(size_t)t * 1024 + 512]), lb = bf2f(pb[(size_t)t * 1024 + 512]); hb = __builtin_amdgcn_exp2f(la) * hb + lb; Ab += la; } }
    __syncthreads();
    sA[seg * 64 + lane] = As; sH[seg * 64 + lane] = hf; sA[512 + seg * 64 + lane] = Ab; sH[512 + seg * 64 + lane] = hb;
    __syncthreads();
    float hinf = 0.f, hinb = 0.f;
    if (lat) { hinf = slru[(size_t)(((seq - 32) * 4 + l) * 2 + 0) * 512 + ch]; hinb = slru[(size_t)(((seq - 32) * 4 + l) * 2 + 1) * 512 + ch]; }
    for (int s = 0; s < seg; ++s) hinf = __builtin_amdgcn_exp2f(sA[s * 64 + lane]) * hinf + sH[s * 64 + lane];
    for (int s = 7; s > seg; --s) hinb = __builtin_amdgcn_exp2f(sA[512 + s * 64 + lane]) * hinb + sH[512 + s * 64 + lane];
    { const bf16_t* pa = LA + (rbase + (size_t)seg * T) * 1024 + ch; const bf16_t* pb = LB + (rbase + (size_t)seg * T) * 1024 + ch; float* ph = HF + (rbase + (size_t)seg * T) * 512 + ch;
      float h = hinf;
#pragma unroll 8
      for (int t = 0; t < T; ++t) { const float la = bf2f(pa[(size_t)t * 1024]), lb = bf2f(pb[(size_t)t * 1024]); h = __builtin_amdgcn_exp2f(la) * h + lb; ph[(size_t)t * 512] = h; }
      if (!lat && seg == 7) out[O_NLRU + (size_t)((seq * 4 + l) * 2 + 0) * 512 + ch] = h;
      asm volatile("s_waitcnt vmcnt(0)" ::: "memory");
      __syncthreads();
      h = hinb;
      const bf16_t* pg = PROJ + (rbase + (size_t)seg * T) * NPROJ + C_LG + ch; bf16_t* po = O + (rbase + (size_t)seg * T) * D + 512 + ch;
#pragma unroll 8
      for (int t = T - 1; t >= 0; --t) { const float la = bf2f(pa[(size_t)t * 1024 + 512]), lb = bf2f(pb[(size_t)t * 1024 + 512]); h = __builtin_amdgcn_exp2f(la) * h + lb;
          const float y = gelu_tanh(bf2f(pg[(size_t)t * NPROJ])) * (ph[(size_t)t * 512] + h); po[(size_t)t * D] = (bf16_t)(pk2(y, 0.f) & 0xffffu); }
      if (!lat && seg == 0) out[O_NLRU + (size_t)((seq * 4 + l) * 2 + 1) * 512 + ch] = h; }
}
__device__ __forceinline__ void m3_ssm_y(const bf16_t* PROJ, const bf16_t* KMl, const bf16_t* CMl, const bf16_t* HS, bf16_t* YS, int unit, int wave, int lane) {
    const int g = unit >> 3, bt0 = (unit & 7) * 12, fr = lane & 15, G4 = lane >> 4;
    const bf16_t* KMg = KMl + (size_t)g * 65536; const bf16_t* CMg = CMl + (size_t)g * 65536;
    bf16x8 kf[2][8], cf[2][8];
#pragma unroll
    for (int qi = 0; qi < 2; ++qi)
#pragma unroll
        for (int ks = 0; ks < 8; ++ks) { kf[qi][ks] = *(const bf16x8*)(KMg + (size_t)((2 * wave + qi) * 16 + fr) * 256 + ks * 32 + G4 * 8); cf[qi][ks] = *(const bf16x8*)(CMg + (size_t)((2 * wave + qi) * 16 + fr) * 256 + ks * 32 + G4 * 8); }
    for (int bt = bt0; bt < bt0 + 12; ++bt) {
        const int chunk = bt * 16 + fr;
        const bf16_t* up = PROJ + (size_t)(chunk * 16 + (G4 >> 1)) * NPROJ + C_SU + 16 * g + 8 * (G4 & 1);
        const bf16_t* hp = HS + ((size_t)chunk * 32 + g) * 256 + G4 * 8;
        f32x4 acc[2] = {(f32x4){0.f, 0.f, 0.f, 0.f}, (f32x4){0.f, 0.f, 0.f, 0.f}};
#pragma unroll
        for (int ks = 0; ks < 8; ++ks) { const bf16x8 bu = *(const bf16x8*)(up + (size_t)(2 * ks) * NPROJ), bh = *(const bf16x8*)(hp + ks * 32);
            acc[0] = mfma16(kf[0][ks], bu, acc[0]); acc[1] = mfma16(kf[1][ks], bu, acc[1]); acc[0] = mfma16(cf[0][ks], bh, acc[0]); acc[1] = mfma16(cf[1][ks], bh, acc[1]); }
#pragma unroll
        for (int qi = 0; qi < 2; ++qi) { const int t = 2 * wave + qi; u32x2 w; w.x = pk2(gelu_tanh(acc[qi][0]), gelu_tanh(acc[qi][1])); w.y = pk2(gelu_tanh(acc[qi][2]), gelu_tanh(acc[qi][3]));
            *(u32x2*)(YS + (size_t)(chunk * 16 + t) * 512 + g * 16 + 4 * G4) = w; }
    }
}
__device__ __forceinline__ void m3_ret_out(const bf16_t* PROJ, const bf16_t* SIN, bf16_t* O, const float* decl, const float* gnl, LAS unsigned char* lds, int unit, int tid, int wave, int lane) {
    const int cn = unit >> 2, hh = unit & 3, fr = lane & 15, G4 = lane >> 4;
    LAS unsigned char* Ks = lds; LAS unsigned char* Vs = lds + 128 * 272;
    const size_t row0 = (size_t)cn * 128;
    const float lgf = ret_log2gamma(decl[hh]), lgb = ret_log2gamma(decl[4 + hh]), scale = 0.08838834764831845f;
    __syncthreads();
    stage_rows<128>(Ks, 272, PROJ + row0 * NPROJ + C_RK + hh * 128, NPROJ, tid);
    stage_rows<128>(Vs, 288, PROJ + row0 * NPROJ + C_RV + hh * 128, NPROJ, tid);
    const int i = wave * 16 + fr;
    bf16x8 qf[4];
    { const bf16_t* qp = PROJ + (row0 + i) * NPROJ + C_RQ + hh * 128 + G4 * 8;
#pragma unroll
      for (int ks = 0; ks < 4; ++ks) qf[ks] = *(const bf16x8*)(qp + ks * 32); }
    __syncthreads();
    bf16x8 pf[4];
    {   f32x4 sa[8];
#pragma unroll
        for (int jt = 0; jt < 8; ++jt) { sa[jt] = (f32x4){0.f, 0.f, 0.f, 0.f};
#pragma unroll
            for (int ks = 0; ks < 4; ++ks) sa[jt] = mfma16(*(const LAS bf16x8*)(Ks + (jt * 16 + fr) * 272 + (ks * 32 + G4 * 8) * 2), qf[ks], sa[jt]); }
#pragma unroll
        for (int jt = 0; jt < 8; ++jt)
#pragma unroll
            for (int r = 0; r < 4; ++r) { const int dlt = i - (16 * jt + 4 * G4 + r); float f = 0.f;
                if (dlt >= 0) f += __builtin_amdgcn_exp2f((float)dlt * lgf); if (dlt <= 0) f += __builtin_amdgcn_exp2f((float)(-dlt) * lgb); sa[jt][r] *= f * scale; }
#pragma unroll
        for (int s = 0; s < 4; ++s) pf[s] = pack8(sa[2 * s], sa[2 * s + 1]);
    }
    const float wfi = __builtin_amdgcn_exp2f((float)(i + 1) * lgf) * scale, wbi = __builtin_amdgcn_exp2f((float)(128 - i) * lgb) * scale;
    const bf16_t* Sf = SIN + (size_t)((cn * 4 + hh) * 2) * 16384 + (size_t)fr * 128 + G4 * 8; const bf16_t* Sb = Sf + 16384;
    f32x4 o[8]; float sum = 0.f;
#pragma unroll
    for (int mt = 0; mt < 8; ++mt) {
        f32x4 oi = (f32x4){0.f, 0.f, 0.f, 0.f}, of = oi, ob = oi;
#pragma unroll
        for (int s = 0; s < 4; ++s) { oi = mfma16(frag_tr(Vs, 288, 32 * s + 4 * G4, 32 * s + 16 + 4 * G4, 16 * mt, lane), pf[s], oi);
            of = mfma16(*(const bf16x8*)(Sf + (size_t)mt * 2048 + s * 32), qf[s], of); ob = mfma16(*(const bf16x8*)(Sb + (size_t)mt * 2048 + s * 32), qf[s], ob); }
        o[mt] = oi + of * wfi + ob * wbi; sum += (o[mt][0] + o[mt][1]) + (o[mt][2] + o[mt][3]);
    }
    sum += __shfl_xor(sum, 16); sum += __shfl_xor(sum, 32);
    const float mu = sum * (1.0f / 128.0f); float q = 0.f;
#pragma unroll
    for (int mt = 0; mt < 8; ++mt) { o[mt] = o[mt] - mu; q += (o[mt][0] * o[mt][0] + o[mt][1] * o[mt][1]) + (o[mt][2] * o[mt][2] + o[mt][3] * o[mt][3]); }
    q += __shfl_xor(q, 16); q += __shfl_xor(q, 32);
    const float rstd = rsqrtf(q * (1.0f / 128.0f) + EPS);
#pragma unroll
    for (int mt = 0; mt < 8; ++mt) { const int dv0 = 16 * mt + 4 * G4; const f32x4 gn4 = *(const f32x4*)(gnl + hh * 128 + dv0);
        const u32x2 gw = *(const u32x2*)(PROJ + (row0 + i) * NPROJ + C_RG + hh * 128 + dv0);
        const float g0 = siluf_(bflo(gw.x)), g1 = siluf_(bfhi(gw.x)), g2 = siluf_(bflo(gw.y)), g3 = siluf_(bfhi(gw.y));
        u32x2 w; w.x = pk2(o[mt][0] * rstd * gn4[0] * g0, o[mt][1] * rstd * gn4[1] * g1); w.y = pk2(o[mt][2] * rstd * gn4[2] * g2, o[mt][3] * rstd * gn4[3] * g3);
        *(u32x2*)(O + (row0 + i) * D + hh * 128 + dv0) = w; }
}
#ifndef PH_PRO
#define PH_PRO 1
#endif
#ifndef PH_NORM1
#define PH_NORM1 1
#endif
#ifndef PH_GIN
#define PH_GIN 1
#endif
#ifndef PH_M1
#define PH_M1 1
#endif
#ifndef PH_M2
#define PH_M2 1
#endif
#ifndef PH_M3
#define PH_M3 1
#endif
#ifndef PH_M4
#define PH_M4 1
#endif
#ifndef PH_GP
#define PH_GP 1
#endif
#ifndef PH_GG
#define PH_GG 1
#endif
#ifndef PH_GO
#define PH_GO 1
#endif
#ifndef PH_NORM2
#define PH_NORM2 1
#endif
#ifndef PH_FFN
#define PH_FFN 1
#endif

struct Args { const float* in[N_IN]; float* out; unsigned char* ws; };
__global__ void __launch_bounds__(512, 2) fwd_kernel(Args a) {
    extern __shared__ __attribute__((aligned(16))) unsigned char lds_raw[];
    LAS unsigned char* lds = (LAS unsigned char*)lds_raw;
    int tid = threadIdx.x; const int bid = blockIdx.x, G = gridDim.x, NT = G * 512, NGW = G * 8;
    int lane, wave, gtid, gw;
#define REIDX() do { tid = threadIdx.x; asm volatile("" : "+v"(tid)); lane = tid & 63; wave = __builtin_amdgcn_readfirstlane(tid >> 6); gtid = bid * 512 + tid; gw = bid * 8 + wave; } while (0)
    REIDX();
    unsigned char* ws = (unsigned char*)in_tab()[N_IN + 1]; float* out = (float*)in_tab()[N_IN];
    if (tid < 4) ((LAS unsigned*)(lds + LDS_MISC))[tid] = 0u;
    __syncthreads();
    XcdBarrier bar = xcd_barrier_post((unsigned*)(ws + WS_CTL) + CW_BAR, (volatile LAS unsigned*)(lds + LDS_MISC));
#define GRID_BAR() do { XcdBarrier b2_ = bar; asm volatile("" : "+s"(b2_.x)); xcd_barrier(b2_); } while (0)
    float* MOD = (float*)(ws + WS_MOD);
    bf16_t* H = (bf16_t*)(ws + WS_H); bf16_t* PROJ = (bf16_t*)(ws + WS_PROJ); bf16_t* OB = (bf16_t*)(ws + WS_O); bf16_t* PB = (bf16_t*)(ws + WS_P); bf16_t* MG = (bf16_t*)(ws + WS_MG);
    bf16_t* XC = (bf16_t*)(ws + WS_XC); bf16_t* LA = (bf16_t*)(ws + WS_LA); bf16_t* LB = (bf16_t*)(ws + WS_LB); float* HF = (float*)(ws + WS_HF); bf16_t* YS = (bf16_t*)(ws + WS_YS);
    float* BU = (float*)(ws + WS_BU); bf16_t* HS = (bf16_t*)(ws + WS_HS); float* KV = (float*)(ws + WS_KV); bf16_t* SIN = (bf16_t*)(ws + WS_SIN);
    float* X = out;

#if PH_PRO
        REIDX();
    prologue_weights(in_tab(), ws, lds, gw, NGW, wave, lane);
    prologue_lru_w(in_tab(), ws, gtid, NT);
    __syncthreads();
    prologue_mod(in_tab(), ws, lds, bid, G, tid, wave, lane);
    prologue_ssm(in_tab(), ws, lds, (bid + 128) % G, G, tid);
#endif
    GRID_BAR();

    for (int l = 0; l < DEPTH; ++l) {
        const float* modl = MOD + (size_t)l * 9 * 12288;
#if PH_NORM1
        REIDX();
        norm_phase(INP(I_XP), INP(I_XS), X, l == 0, INP(I_NORM1) + l * D, modl, 0, 1, H, gw, NGW, lane);
#endif
        GRID_BAR();
#if PH_GIN
        REIDX();
        { pg8::Gemm g{H, (const bf16_t*)(ws + WS_WIN1) + (size_t)l * NPROJ * D, MTOK, NPROJ, D, D, D, 1 << 20, 0}; pg8::StaticOrder S; S.init(MTOK, NPROJ, G, bid);
          EpiStore E{PROJ, NPROJ, 0}; pg8::gemm_phase<EpiStore>(lds, g, S, E); }
#endif
        GRID_BAR();
#if PH_M1
        REIDX();
        m1_attn_prep(PROJ, INP(I_QN) + l * 128, INP(I_KN) + l * 128, out, l, gtid, NT);
        m1_lru_conv(PROJ, XC, INP(I_LCW) + l * 4 * 512, INP(I_LCB) + l * 512, gtid, NT);
        for (int u = bid; u < 256; u += G) m1_ssm_bu(PROJ, (const bf16_t*)(ws + WS_SSMB) + (size_t)l * 32 * 65536, BU, u, wave, lane);
        for (int u = bid; u < NCHUNK128 * 4; u += G) m1_ret_kv(PROJ, KV, INP(I_RDEC) + l * 8, lds, u, tid, wave, lane);
#endif
        GRID_BAR();
#if PH_M2
        REIDX();
        { pg8::Gemm g{XC, (const bf16_t*)(ws + WS_WLRU) + (size_t)l * 2048 * 512, MTOK, 2048, 512, 512, 512, 1 << 20, 0}; pg8::StaticOrder S; S.init(MTOK, 2048, G, bid);
          EpiLru E{XC, LA, LB, INP(I_LBA) + l * 1024, INP(I_LBX) + l * 1024, INP(I_LLAM) + l * 1024}; pg8::gemm_phase<EpiLru>(lds, g, S, E); }
        for (int u = bid; u < 768; u += G) m2_attn_unit(PROJ, INP(I_CK), INP(I_CV), OB, INP(I_SINK) + l * 4, lds, u, l, tid, wave, lane);
        for (int it = bid; it < 320; it += G) m2_ssm_scan(BU, HS, (const float*)(ws + WS_A16) + (size_t)l * 2 * 32 * 64 * 2, INP(I_SSRE), INP(I_SSIM), out, l, it, tid);
        m2_ret_scan(KV, SIN, INP(I_SRET), INP(I_RDEC) + l * 8, out, l, gtid, NT);
#endif
        GRID_BAR();
#if PH_M3
        REIDX();
        for (int t = bid; t < 320; t += G) m3_lru_scan(LA, LB, HF, PROJ, OB, INP(I_SLRU), out, lds, l, t, wave, lane);
        for (int u = bid; u < 256; u += G) m3_ssm_y(PROJ, (const bf16_t*)(ws + WS_SSMK) + (size_t)l * 32 * 65536, (const bf16_t*)(ws + WS_SSMC) + (size_t)l * 32 * 65536, HS, YS, u, wave, lane);
        for (int u = bid; u < NCHUNK128 * 4; u += G) m3_ret_out(PROJ, SIN, OB, INP(I_RDEC) + l * 8, INP(I_RGN) + l * 512, lds, u, tid, wave, lane);
#endif
        GRID_BAR();
#if PH_M4
        REIDX();
        { pg8::Gemm g{YS, (const bf16_t*)(ws + WS_WGLU) + (size_t)l * 512 * 512, MTOK, 512, 512, 512, 512, 1 << 20, 0}; pg8::StaticOrder S; S.init(MTOK, 512, G, bid);
          EpiGlu E{YS, OB, INP(I_SBGLU) + l * 512}; pg8::gemm_phase<EpiGlu>(lds, g, S, E); }
#endif
        GRID_BAR();
#if PH_GP
        REIDX();
        { pg8::Gemm g{OB, (const bf16_t*)(ws + WS_WBR) + (size_t)l * 8192 * 512, MTOK, 8192, 512, D, 512, 8, 512}; pg8::StaticOrder S; S.init(MTOK, 8192, G, bid);
          EpiStore E{PB, 8192, 0}; pg8::gemm_phase<EpiStore>(lds, g, S, E); }
#endif
        GRID_BAR();
#if PH_GG
        REIDX();
        { pg8::Gemm g{H, (const bf16_t*)(ws + WS_WGATE) + (size_t)l * 8192 * D, MTOK, 8192, D, D, D, 1 << 20, 0}; pg8::StaticOrder S; S.init(MTOK, 8192, G, bid);
          EpiGate E{PB, MG}; pg8::gemm_phase<EpiGate>(lds, g, S, E); }
#endif
        GRID_BAR();
#if PH_GO
        REIDX();
        { pg8::Gemm g{MG, (const bf16_t*)(ws + WS_WOUT) + (size_t)l * D * D, MTOK, D, D, D, D, 1 << 20, 0}; pg8::StaticOrder S; S.init(MTOK, D, G, bid);
          EpiResid E{X, modl + 2 * 2048}; pg8::gemm_phase<EpiResid>(lds, g, S, E); }
#endif
        GRID_BAR();
#if PH_NORM2
        REIDX();
        norm_phase(nullptr, nullptr, X, false, INP(I_NORM2) + l * D, modl, 3, 4, H, gw, NGW, lane);
#endif
        GRID_BAR();
#if PH_FFN
        REIDX();
        { pg8::Gemm g{H, (const bf16_t*)(ws + WS_WFF1) + (size_t)l * DFF * D, MTOK, DFF, D, D, D, 1 << 20, 0}; pg8::StaticOrder S; S.init(MTOK, DFF, G, bid);
          EpiStore E{PB, DFF, 1}; pg8::gemm_phase<EpiStore>(lds, g, S, E); }
        GRID_BAR();
        { pg8::Gemm g{PB, (const bf16_t*)(ws + WS_WFF2) + (size_t)l * D * DFF, MTOK, D, DFF, DFF, DFF, 1 << 20, 0}; pg8::StaticOrder S; S.init(MTOK, D, G, bid);
          EpiResid E{X, modl + 5 * 2048}; pg8::gemm_phase<EpiResid>(lds, g, S, E); }
        GRID_BAR();
#endif
    }
}

extern "C" void kernel_launch(void* const* d_in, const int* in_sizes, int n_in, void* d_out, int out_size, void* d_ws, size_t ws_size, hipStream_t stream) {
    static int grid = 0;
    if (grid == 0) {
        if (n_in != N_IN || (size_t)out_size != O_END || ws_size < WS_END) { fprintf(stderr, "kernel_launch: unexpected shapes (n_in %d, out %d, ws %zu; need ws >= %zu)\n", n_in, out_size, ws_size, (size_t)WS_END); grid = -1; return; }
        int dev = 0, cus = 0;
        if (hipGetDevice(&dev) != hipSuccess || hipDeviceGetAttribute(&cus, hipDeviceAttributeMultiprocessorCount, dev) != hipSuccess) { grid = -1; return; }
        if (hipFuncSetAttribute((const void*)fwd_kernel, hipFuncAttributeMaxDynamicSharedMemorySize, LDS_BYTES) != hipSuccess) { fprintf(stderr, "kernel_launch: hipFuncSetAttribute failed\n"); grid = -1; return; }
        int per_cu = 0;
        if (hipOccupancyMaxActiveBlocksPerMultiprocessor(&per_cu, (const void*)fwd_kernel, 512, LDS_BYTES) != hipSuccess || per_cu < 1) { fprintf(stderr, "kernel_launch: occupancy query says %d blocks per CU\n", per_cu); grid = -1; (void)hipGetLastError(); return; }
        grid = cus;
    }
    if (grid < 0) return;
    (void)hipMemsetAsync((char*)d_ws + WS_CTL, 0, CTL_ZERO_BYTES, stream);
    Args a{};
    for (int i = 0; i < N_IN; ++i) a.in[i] = (const float*)d_in[i];
    a.out = (float*)d_out; a.ws = (unsigned char*)d_ws;
    hipLaunchKernelGGL(fwd_kernel, dim3(grid), dim3(512), LDS_BYTES, stream, a);
}
```

```cpp
#include <hip/hip_runtime.h>
#include <cstdio>
#include <cstdint>

#define LAS __attribute__((address_space(3)))
typedef unsigned short bf16_t;
typedef short bf16x8 __attribute__((ext_vector_type(8)));
typedef short s16x4 __attribute__((ext_vector_type(4)));
typedef float f32x4 __attribute__((ext_vector_type(4)));
typedef float f32x2 __attribute__((ext_vector_type(2)));
typedef unsigned u32x4 __attribute__((ext_vector_type(4)));
typedef unsigned u32x2 __attribute__((ext_vector_type(2)));

namespace pg8 {
constexpr int BM = 256, BK = 64, HALF = 128, HTB = HALF * BK * 2, STAGE_BYTES = 8 * HTB, NXCD = 8, WGM = 8;
__host__ __device__ __forceinline__ int lds_byte(int r, int c) { const int st = (r >> 4) * 2 + (c >> 5), rr = r & 15, cc = c & 31, ob = rr * 64 + cc * 2; return st * 1024 + (ob ^ (((ob >> 9) & 1) << 5)); }
__host__ __device__ __forceinline__ void stage_rc(int b, int& R, int& C) { const int st = b / 1024, sb = b % 1024, swz = sb ^ (((sb >> 9) & 1) << 5); R = (st >> 1) * 16 + swz / 64; C = (st & 1) * 32 + (swz % 64) / 2; }
__host__ __device__ __forceinline__ int perm32(int rho) { const int n = rho >> 4, i = rho & 15; return 8 * (i >> 2) + 4 * n + (i & 3); }
struct Unit { int pm, pn; };
struct Gemm { const bf16_t* A; const bf16_t* Bt; int M, N, K, lda, ldb, a_grp, a_gstride; };
struct StaticOrder {
    int nM, nN, nwg, G, c;
    __host__ __device__ void init(int M, int N, int G_, int c_) { nM = M / BM; nN = N / BM; nwg = nM * nN; G = G_; c = c_; }
    __host__ __device__ bool next(int i, Unit& u) const {
        const long L = (long)i * G + c; if (L >= nwg) return false;
        int wgid = (int)L; { const int q = nwg / NXCD, r = nwg % NXCD, xcd = wgid % NXCD, off = wgid / NXCD; wgid = (xcd < r ? xcd * (q + 1) : r * (q + 1) + (xcd - r) * q) + off; }
        const int nig = WGM * nN, gid = wgid / nig, fm = gid * WGM, gsz = (nM - fm) < WGM ? (nM - fm) : WGM;
        u.pm = fm + ((wgid % nig) % gsz); u.pn = (wgid % nig) / gsz; return true;
    }
};
__device__ __forceinline__ unsigned cvt_pk_bf16(float lo, float hi) { unsigned r; asm volatile("v_cvt_pk_bf16_f32 %0, %1, %2" : "=v"(r) : "v"(lo), "v"(hi)); return r; }

template <class Epi>
__device__ __forceinline__ void gemm_phase(LAS unsigned char* lds, const Gemm g, const StaticOrder& S, const Epi& E) {
    int tid = threadIdx.x; asm volatile("" : "+v"(tid)); const int wid = __builtin_amdgcn_readfirstlane(tid >> 6), lane = tid & 63, wr = wid >> 2, wc = wid & 3, fr = lane & 15, fq = lane >> 4;
    const int K = g.K, nt = K / BK;
    unsigned voffA[2], voffB[2];
#pragma unroll
    for (int i = 0; i < 2; ++i) { int R, C; stage_rc(tid * 16 + i * 8192, R, C); const int Rb = Epi::PERM ? ((R & ~31) + perm32(R & 31)) : R;
        voffA[i] = (unsigned)(R * g.lda + C) * 2u; voffB[i] = (unsigned)(Rb * g.ldb + C) * 2u; }
    const size_t kstep = (size_t)(BK * 2);
    const size_t hsA = (size_t)HALF * g.lda * 2, hsB = (size_t)HALF * g.ldb * 2;
    const unsigned ldsw = (unsigned)wid * 1024u;
    const int aoff = lds_byte(wr * 64 + fr, fq * 8), boff = lds_byte(wc * 32 + fr, fq * 8);
#define PG8_SA(b, h) (((b) * 2 + (h)) * HTB)
#define PG8_SB(b, h) ((4 + (b) * 2 + (h)) * HTB)
#define PG8_STAGE(bufoff, gbase, voff) do { _Pragma("unroll") for (int _i = 0; _i < 2; ++_i) \
        __builtin_amdgcn_global_load_lds((const unsigned*)((const char*)(gbase) + (voff)[_i]), (LAS unsigned*)(lds + (bufoff) + ldsw + _i * 8192), 16, 0, 0); } while (0)
#define PG8_LDA(dst, b, h) do { _Pragma("unroll") for (int m = 0; m < 4; ++m) _Pragma("unroll") for (int k = 0; k < 2; ++k) dst[m][k] = *(const LAS bf16x8*)(lds + PG8_SA(b, h) + aoff + m * 2048 + k * 1024); } while (0)
#define PG8_LDB(dst, b, h) do { _Pragma("unroll") for (int n = 0; n < 2; ++n) _Pragma("unroll") for (int k = 0; k < 2; ++k) dst[n][k] = *(const LAS bf16x8*)(lds + PG8_SB(b, h) + boff + n * 2048 + k * 1024); } while (0)
#define PG8_MMA(ai, bj, At, Bt) do { __builtin_amdgcn_s_setprio(1); _Pragma("unroll") for (int m = 0; m < 4; ++m) _Pragma("unroll") for (int n = 0; n < 2; ++n) _Pragma("unroll") for (int k = 0; k < 2; ++k) \
        acc[ai][bj][m][n] = __builtin_amdgcn_mfma_f32_16x16x32_bf16(Bt[n][k], At[m][k], acc[ai][bj][m][n], 0, 0, 0); __builtin_amdgcn_s_setprio(0); } while (0)
#define PG8_WAIT_V(n) asm volatile("s_waitcnt vmcnt(" #n ")" ::: "memory")
#define PG8_WAIT_L(n) asm volatile("s_waitcnt lgkmcnt(" #n ")" ::: "memory")
#define PG8_BAR __builtin_amdgcn_s_barrier()
#define PG8_SCHED __builtin_amdgcn_sched_barrier(0)
#define PG8_UA(u) ((const char*)g.A + (size_t)(u).pm * 2 * hsA + (size_t)(((u).pn / g.a_grp) * g.a_gstride) * 2)
#define PG8_UB(u) ((const char*)g.Bt + (size_t)(u).pn * 2 * hsB)
    Unit cur, nxt; int ui = 0;
    if (!S.next(0, cur)) return;
    f32x4 acc[2][2][4][2];
#pragma unroll
    for (int a = 0; a < 2; ++a)
#pragma unroll
        for (int b = 0; b < 2; ++b)
#pragma unroll
            for (int m = 0; m < 4; ++m)
#pragma unroll
                for (int n = 0; n < 2; ++n) acc[a][b][m][n] = (f32x4){0.f, 0.f, 0.f, 0.f};
    bf16x8 At[4][2], B0[2][2], B1[2][2];
    const char* cA = PG8_UA(cur); const char* cB = PG8_UB(cur);
    PG8_STAGE(PG8_SB(0, 0), cB, voffB); PG8_STAGE(PG8_SB(0, 1), cB + hsB, voffB); PG8_STAGE(PG8_SA(0, 0), cA, voffA); PG8_STAGE(PG8_SA(0, 1), cA + hsA, voffA);
    if (wr == 1) PG8_BAR;
    PG8_WAIT_V(2); PG8_BAR;
    PG8_STAGE(PG8_SB(1, 0), cB + kstep, voffB); PG8_STAGE(PG8_SA(1, 0), cA + kstep, voffA); PG8_STAGE(PG8_SB(1, 1), cB + hsB + kstep, voffB);
    PG8_WAIT_V(6); PG8_BAR;
    for (;;) {
        const bool has_next = S.next(ui + 1, nxt);
        const char* nA = has_next ? PG8_UA(nxt) : cA; const char* nB = has_next ? PG8_UB(nxt) : cB;
        for (int t = 0; t < nt; t += 2) {
            const bool last = (t == nt - 2);
            const char* a1 = cA + (size_t)(t + 1) * kstep;
            const char* a2 = last ? nA : cA + (size_t)(t + 2) * kstep; const char* b2 = last ? nB : cB + (size_t)(t + 2) * kstep;
            const char* a3 = a2 + kstep; const char* b3 = b2 + kstep;
            PG8_LDB(B0, 0, 0); PG8_LDB(B1, 0, 1); PG8_SCHED; PG8_LDA(At, 0, 0); PG8_STAGE(PG8_SA(1, 1), a1 + hsA, voffA);
            PG8_WAIT_V(8); PG8_WAIT_L(0); PG8_BAR; PG8_MMA(0, 0, At, B0); PG8_MMA(0, 1, At, B1); PG8_BAR; PG8_SCHED;
            PG8_LDA(At, 0, 1); PG8_STAGE(PG8_SB(0, 0), b2, voffB); PG8_STAGE(PG8_SB(0, 1), b2 + hsB, voffB); PG8_STAGE(PG8_SA(0, 0), a2, voffA);
            PG8_WAIT_V(8); PG8_WAIT_L(0); PG8_BAR; PG8_MMA(1, 0, At, B0); PG8_MMA(1, 1, At, B1); PG8_BAR; PG8_SCHED;
            PG8_LDB(B0, 1, 0); PG8_LDB(B1, 1, 1); PG8_SCHED; PG8_LDA(At, 1, 0); PG8_STAGE(PG8_SA(0, 1), a2 + hsA, voffA);
            PG8_WAIT_V(8); PG8_WAIT_L(0); PG8_BAR; PG8_MMA(0, 0, At, B0); PG8_MMA(0, 1, At, B1); PG8_BAR; PG8_SCHED;
            PG8_LDA(At, 1, 1); PG8_STAGE(PG8_SB(1, 0), b3, voffB); PG8_STAGE(PG8_SB(1, 1), b3 + hsB, voffB); PG8_STAGE(PG8_SA(1, 0), a3, voffA);
            PG8_WAIT_V(8); PG8_WAIT_L(0); PG8_BAR; PG8_MMA(1, 0, At, B0); PG8_MMA(1, 1, At, B1); PG8_BAR; PG8_SCHED;
        }
        if (wr == 0) PG8_BAR;
        E(acc, cur, wr, wc, fr, fq);
        if (!has_next) break;
#pragma unroll
        for (int a = 0; a < 2; ++a)
#pragma unroll
            for (int b = 0; b < 2; ++b)
#pragma unroll
                for (int m = 0; m < 4; ++m)
#pragma unroll
                    for (int n = 0; n < 2; ++n) acc[a][b][m][n] = (f32x4){0.f, 0.f, 0.f, 0.f};
        cur = nxt; cA = nA; cB = nB; ++ui;
        if (wr == 1) PG8_BAR;
    }
    PG8_WAIT_V(0);
    PG8_BAR;
#undef PG8_SA
#undef PG8_SB
#undef PG8_STAGE
#undef PG8_LDA
#undef PG8_LDB
#undef PG8_MMA
#undef PG8_WAIT_V
#undef PG8_WAIT_L
#undef PG8_BAR
#undef PG8_SCHED
#undef PG8_UA
#undef PG8_UB
}
}
#define XB_TMO      128
#define XB_XCNT(j)  (256  + 64 * (j))
#define XB_XSUB(j)  (1280 + 64 * (j))
#define XB_XGEN(j)  (2304 + 64 * (j))
#define XB_TOP      3328
#define XB_TOPGEN   3392
#define XCD_BAR_WORDS 3456
#define XB_SPIN_CAP (1u << 18)

__device__ __forceinline__ unsigned xb_ld(unsigned* p)              { return __hip_atomic_load(p, __ATOMIC_RELAXED, __HIP_MEMORY_SCOPE_AGENT); }
__device__ __forceinline__ unsigned xb_add(unsigned* p, unsigned v) { return __hip_atomic_fetch_add(p, v, __ATOMIC_RELAXED, __HIP_MEMORY_SCOPE_AGENT); }
__device__ __forceinline__ unsigned xb_xcc_id() { return (unsigned)__builtin_amdgcn_s_getreg((3 << 11) | 20) & 0xFu; }
#define XB_SPIN(cond, bar) do { unsigned _sp = 0; while (cond) { __builtin_amdgcn_s_sleep(1); \
    if ((++_sp & 255u) == 0u) { if (xb_ld(&(bar)[XB_TMO])) break; if (_sp > XB_SPIN_CAP) { atomicAdd(&(bar)[XB_TMO], 1u); break; } } } } while (0)

struct XcdBarrier {
    unsigned* bar; unsigned x;
    volatile LAS unsigned* st;
};

__device__ __forceinline__ XcdBarrier xcd_barrier_post(unsigned* bar, volatile LAS unsigned* st) {
    XcdBarrier b; b.bar = bar; b.x = xb_xcc_id(); b.st = st;
    if (threadIdx.x == 0) (void)xb_add(&bar[XB_XCNT(b.x)], 1u);
    return b;
}
__device__ __forceinline__ void xcd_barrier_complete(unsigned* bar, unsigned x, unsigned& nloc, unsigned& nx) {
    const unsigned G = gridDim.x * gridDim.y * gridDim.z;
    unsigned sum, cnt, mine, sp = 0u;
    for (;;) {
        sum = 0u; cnt = 0u; mine = 0u;
#pragma unroll
        for (unsigned j = 0; j < 16; ++j) { const unsigned c = xb_ld(&bar[XB_XCNT(j)]); sum += c; cnt += (c > 0u) ? 1u : 0u; mine = (j == x) ? c : mine; }
        if (sum == G) break;
        __builtin_amdgcn_s_sleep(1);
        if ((++sp & 255u) == 0u) { if (xb_ld(&bar[XB_TMO])) break; if (sp > XB_SPIN_CAP) { atomicAdd(&bar[XB_TMO], 1u); break; } }
    }
    nloc = mine > 0u ? mine : 1u; nx = cnt > 0u ? cnt : 1u;
}

__device__ __forceinline__ void xcd_barrier(const XcdBarrier& b) {
    asm volatile("s_waitcnt vmcnt(0)" ::: "memory");
    __syncthreads();
    if (threadIdx.x == 0) {
        unsigned* bar = b.bar;
        __builtin_amdgcn_s_waitcnt(0);
        unsigned nloc = b.st[0], nx = b.st[1];
        if (nloc == 0u) { xcd_barrier_complete(bar, b.x, nloc, nx); b.st[0] = nloc; b.st[1] = nx; }
        const unsigned old = xb_add(&bar[XB_XSUB(b.x)], 1u);
        const unsigned gen = old / nloc;
        if (old + 1u == (gen + 1u) * nloc) {
            __builtin_amdgcn_fence(__ATOMIC_RELEASE, "agent");
            asm volatile("s_waitcnt vmcnt(0)" ::: "memory");
            const unsigned og = xb_add(&bar[XB_TOP], 1u);
            const unsigned tg = og / nx;
            if (og + 1u == (tg + 1u) * nx) xb_add(&bar[XB_TOPGEN], 1u);
            else XB_SPIN(xb_ld(&bar[XB_TOPGEN]) == tg, bar);
            __builtin_amdgcn_fence(__ATOMIC_ACQUIRE, "agent");
            xb_add(&bar[XB_XGEN(b.x)], 1u);
            asm volatile("s_waitcnt vmcnt(0)" ::: "memory");
        } else {
            XB_SPIN(xb_ld(&bar[XB_XGEN(b.x)]) == gen, bar);
            __builtin_amdgcn_fence(__ATOMIC_ACQUIRE, "agent");
            asm volatile("s_waitcnt vmcnt(0)" ::: "memory");
        }
    }
    __syncthreads();
}

constexpr int D = 2048, MCTX = 8192, MLAT = 16384, MTOK = 24576, DEPTH = 4, DFF = 8192;
constexpr int NPROJ = 4608;
constexpr int C_RQ = 0, C_RK = 512, C_RV = 1024, C_RG = 1536, C_LX = 2048, C_LG = 2560, C_AQ = 3072, C_AK = 3584, C_AV = 3840, C_SU = 4096;
constexpr int NCHUNK16 = MTOK / 16;
constexpr int NCHUNK128 = MTOK / 128;
constexpr float EPS = 1e-6f, LOG2E = 1.4426950408889634f;
enum { I_XP = 0, I_XS, I_CK, I_CV, I_SRET, I_SLRU, I_SSRE, I_SSIM, I_C, I_CCTX, I_WMOD, I_BMOD, I_NORM1, I_WIN, I_RDEC, I_RGN, I_LCW, I_LCB, I_LWA, I_LBA, I_LWX, I_LBX, I_LLAM,
       I_QN, I_KN, I_SINK, I_SARE, I_SAIM, I_SLDT, I_SBRE, I_SBIM, I_SCRE, I_SCIM, I_SD, I_SWGLU, I_SBGLU, I_WBR, I_WOUT, I_NORM2, I_WFF1, I_WFF2, N_IN };
constexpr size_t O_YP = 0, O_YS = 16777216, O_NK = 50331648, O_NV = 58720256, O_NRET = 67108864, O_NLRU = 83886080, O_NSRE = 84017152, O_NSIM = 84541440, O_END = 85065728;
constexpr size_t MiB = 1u << 20;
constexpr size_t WS_CTL = 0, CTL_ZERO_BYTES = 1 * MiB;
constexpr size_t WS_MOD = 1 * MiB;
constexpr size_t WS_A16 = 3 * MiB;
constexpr size_t WS_SSMK = 4 * MiB;
constexpr size_t WS_SSMC = 20 * MiB;
constexpr size_t WS_SSMB = 36 * MiB;
constexpr size_t WS_WGLU = 52 * MiB;
constexpr size_t WS_WLRU = 54 * MiB;
constexpr size_t WS_WIN1 = 62 * MiB;
constexpr size_t WS_WGATE = 134 * MiB;
constexpr size_t WS_WBR = 262 * MiB;
constexpr size_t WS_WOUT = 294 * MiB;
constexpr size_t WS_WFF1 = 326 * MiB;
constexpr size_t WS_WFF2 = 454 * MiB;
constexpr size_t WS_H = 582 * MiB;
constexpr size_t WS_PROJ = 678 * MiB;
constexpr size_t WS_O = 894 * MiB;
constexpr size_t WS_P = 990 * MiB;
constexpr size_t WS_MG = 1374 * MiB;
constexpr size_t WS_END = 1470 * MiB;
constexpr size_t WS_XC = WS_P;
constexpr size_t WS_LA = WS_XC + 24 * MiB;
constexpr size_t WS_LB = WS_LA + 48 * MiB;
constexpr size_t WS_HF = WS_LB + 48 * MiB;
constexpr size_t WS_YS = WS_HF + 48 * MiB;
constexpr size_t WS_BU = WS_YS + 24 * MiB;
constexpr size_t WS_HS = WS_BU + 48 * MiB;
constexpr size_t WS_KV = WS_HS + 24 * MiB;
constexpr size_t WS_SIN = WS_KV + 96 * MiB;
static_assert(WS_SIN + 48 * MiB <= WS_END, "mixer temporaries fit");
constexpr int CW_BAR = 4096;
constexpr int LDS_BYTES = 147456, LDS_MISC = 143360;

typedef const float* fptr_t;
typedef __attribute__((address_space(4))) const fptr_t* tab_t;
__device__ __forceinline__ tab_t in_tab() { tab_t t = (tab_t)__builtin_amdgcn_kernarg_segment_ptr(); asm volatile("" : "+s"(t)); return t; }
#define INP(i) (in_tab()[i])
__device__ __forceinline__ float bf2f(unsigned short b) { return __uint_as_float(((unsigned)b) << 16); }
__device__ __forceinline__ float bflo(unsigned w) { return __uint_as_float(w << 16); }
__device__ __forceinline__ float bfhi(unsigned w) { return __uint_as_float(w & 0xffff0000u); }
__device__ __forceinline__ unsigned pk2(float lo, float hi) { return pg8::cvt_pk_bf16(lo, hi); }
__device__ __forceinline__ bf16x8 pack8(const f32x4 a, const f32x4 b) { u32x4 w; w.x = pk2(a[0], a[1]); w.y = pk2(a[2], a[3]); w.z = pk2(b[0], b[1]); w.w = pk2(b[2], b[3]); return __builtin_bit_cast(bf16x8, w); }
__device__ __forceinline__ float sigmoidf_(float x) { return __builtin_amdgcn_rcpf(1.0f + __builtin_amdgcn_exp2f(-x * LOG2E)); }
__device__ __forceinline__ float siluf_(float x) { return x * sigmoidf_(x); }
__device__ __forceinline__ float gelu_tanh(float x) {
    const float u = 0.7978845608028654f * (x + 0.044715f * x * x * x); return x * sigmoidf_(2.0f * u); }
__device__ __forceinline__ f32x4 mfma16(bf16x8 a, bf16x8 b, f32x4 c) { return __builtin_amdgcn_mfma_f32_16x16x32_bf16(a, b, c, 0, 0, 0); }
__device__ __forceinline__ bf16x8 frag_tr(const LAS unsigned char* img, int ldb, int klo, int khi, int n0, int lane) {
    const int q = (lane & 15) >> 2, p = lane & 3;
    const s16x4 lo = __builtin_amdgcn_ds_read_tr16_b64_v4i16((LAS s16x4*)(img + (klo + q) * ldb + (n0 + 4 * p) * 2));
    const s16x4 hi = __builtin_amdgcn_ds_read_tr16_b64_v4i16((LAS s16x4*)(img + (khi + q) * ldb + (n0 + 4 * p) * 2));
    return __builtin_shufflevector(lo, hi, 0, 1, 2, 3, 4, 5, 6, 7);
}
template <int R> __device__ __forceinline__ void stage_rows(LAS unsigned char* img, int ldl, const bf16_t* src, size_t ldg, int tid) {
#pragma unroll
    for (int c = tid; c < R * 16; c += 512) { const int row = c >> 4, ch = c & 15; *(LAS u32x4*)(img + row * ldl + ch * 16) = *(const u32x4*)(src + (size_t)row * ldg + ch * 8); }
}
__device__ __forceinline__ int mod_row(int pm) { return pm < 32 ? 0 : 1 + ((pm - 32) >> 3); }

struct EpiStore {
    static constexpr bool PERM = true;
    bf16_t* O; int ldc; int relu2;
    __device__ __forceinline__ void operator()(const f32x4 (&acc)[2][2][4][2], const pg8::Unit& u, int wr, int wc, int fr, int fq) const {
        const int row0 = u.pm * 256 + wr * 64 + fr, col0 = u.pn * 256 + wc * 32 + 8 * fq;
#pragma unroll
        for (int ai = 0; ai < 2; ++ai)
#pragma unroll
            for (int m = 0; m < 4; ++m) { bf16_t* rowp = O + (size_t)(row0 + ai * 128 + m * 16) * ldc + col0;
#pragma unroll
                for (int bj = 0; bj < 2; ++bj) { f32x4 v0 = acc[ai][bj][m][0], v1 = acc[ai][bj][m][1];
                    if (relu2) {
#pragma unroll
                        for (int j = 0; j < 4; ++j) { const float a = fmaxf(v0[j], 0.f), b = fmaxf(v1[j], 0.f); v0[j] = a * a; v1[j] = b * b; } }
                    u32x4 w; w.x = pk2(v0[0], v0[1]); w.y = pk2(v0[2], v0[3]); w.z = pk2(v1[0], v1[1]); w.w = pk2(v1[2], v1[3]);
                    *(u32x4*)(rowp + bj * 128) = w; } }
    }
};
struct EpiResid {
    static constexpr bool PERM = false;
    const float* X; float* Xo; const float* gmod;
    __device__ __forceinline__ void operator()(const f32x4 (&acc)[2][2][4][2], const pg8::Unit& u, int wr, int wc, int fr, int fq) const {
        const int row0 = u.pm * 256 + wr * 64 + fr, col0 = u.pn * 256 + wc * 32 + 4 * fq;
        const float* gp = gmod + (size_t)mod_row(u.pm) * 12288 + col0;
        f32x4 gv[2][2];
#pragma unroll
        for (int bj = 0; bj < 2; ++bj)
#pragma unroll
            for (int n = 0; n < 2; ++n) gv[bj][n] = *(const f32x4*)(gp + bj * 128 + n * 16);
#pragma unroll
        for (int ai = 0; ai < 2; ++ai)
#pragma unroll
            for (int m = 0; m < 4; ++m) { const size_t ro = (size_t)(row0 + ai * 128 + m * 16) * D + col0;
#pragma unroll
                for (int bj = 0; bj < 2; ++bj)
#pragma unroll
                    for (int n = 0; n < 2; ++n) { const size_t o = ro + bj * 128 + n * 16; *(f32x4*)(Xo + o) = *(const f32x4*)(X + o) + gv[bj][n] * acc[ai][bj][m][n]; } }
    }
};
struct EpiGate {
    static constexpr bool PERM = false;
    const bf16_t* P; bf16_t* MG;
    __device__ __forceinline__ void operator()(const f32x4 (&acc)[2][2][4][2], const pg8::Unit& u, int wr, int wc, int fr, int fq) const {
        const int row0 = u.pm * 256 + wr * 64 + fr, ch0 = u.pn * 64 + wc * 16 + 4 * fq;
#pragma unroll
        for (int ai = 0; ai < 2; ++ai)
#pragma unroll
            for (int m = 0; m < 4; ++m) { const size_t row = (size_t)(row0 + ai * 128 + m * 16);
                f32x4 s = (f32x4){0.f, 0.f, 0.f, 0.f};
#pragma unroll
                for (int b = 0; b < 4; ++b) { const u32x2 pw = *(const u32x2*)(P + row * 8192 + b * 2048 + ch0); const f32x4 a = acc[ai][b >> 1][m][b & 1];
                    s[0] += sigmoidf_(a[0]) * bflo(pw.x); s[1] += sigmoidf_(a[1]) * bfhi(pw.x); s[2] += sigmoidf_(a[2]) * bflo(pw.y); s[3] += sigmoidf_(a[3]) * bfhi(pw.y); }
                u32x2 w; w.x = pk2(s[0], s[1]); w.y = pk2(s[2], s[3]); *(u32x2*)(MG + row * D + ch0) = w; }
    }
};
struct EpiLru {
    static constexpr bool PERM = true;
    const bf16_t* XC; bf16_t* LA; bf16_t* LB; const float* ba; const float* bx; const float* lam;
    __device__ __forceinline__ void operator()(const f32x4 (&acc)[2][2][4][2], const pg8::Unit& u, int wr, int wc, int fr, int fq) const {
        const int row0 = u.pm * 256 + wr * 64 + fr, d = u.pn >> 2, ch0 = (u.pn & 3) * 128 + wc * 32 + 8 * fq;
        float bav[8], bxv[8], spv[8];
#pragma unroll
        for (int e = 0; e < 8; ++e) { bav[e] = ba[d * 512 + ch0 + e]; bxv[e] = bx[d * 512 + ch0 + e]; spv[e] = -8.0f * LOG2E * log1pf(__expf(-lam[d * 512 + ch0 + e])); }
#pragma unroll
        for (int ai = 0; ai < 2; ++ai)
#pragma unroll
            for (int m = 0; m < 4; ++m) { const size_t row = (size_t)(row0 + ai * 128 + m * 16);
                const u32x4 xw = *(const u32x4*)(XC + row * 512 + ch0);
                float xv[8] = {bflo(xw.x), bfhi(xw.x), bflo(xw.y), bfhi(xw.y), bflo(xw.z), bfhi(xw.z), bflo(xw.w), bfhi(xw.w)};
                float la[8], lb[8];
#pragma unroll
                for (int e = 0; e < 8; ++e) { const float r = sigmoidf_(acc[ai][0][m][e >> 2][e & 3] + bav[e]), ig = sigmoidf_(acc[ai][1][m][e >> 2][e & 3] + bxv[e]);
                    const float l2 = r * spv[e], a = __builtin_amdgcn_exp2f(l2); la[e] = l2; lb[e] = sqrtf(fmaxf(1.0f - a * a, 0.f)) * ig * xv[e]; }
                u32x4 w; w.x = pk2(la[0], la[1]); w.y = pk2(la[2], la[3]); w.z = pk2(la[4], la[5]); w.w = pk2(la[6], la[7]);
                *(u32x4*)(LA + row * 1024 + d * 512 + ch0) = w;
                w.x = pk2(lb[0], lb[1]); w.y = pk2(lb[2], lb[3]); w.z = pk2(lb[4], lb[5]); w.w = pk2(lb[6], lb[7]);
                *(u32x4*)(LB + row * 1024 + d * 512 + ch0) = w; }
    }
};
struct EpiGlu {
    static constexpr bool PERM = true;
    const bf16_t* YS; bf16_t* O; const float* bg;
    __device__ __forceinline__ void operator()(const f32x4 (&acc)[2][2][4][2], const pg8::Unit& u, int wr, int wc, int fr, int fq) const {
        const int row0 = u.pm * 256 + wr * 64 + fr, col0 = u.pn * 256 + wc * 32 + 8 * fq;
#pragma unroll
        for (int ai = 0; ai < 2; ++ai)
#pragma unroll
            for (int m = 0; m < 4; ++m) { const size_t row = (size_t)(row0 + ai * 128 + m * 16);
#pragma unroll
                for (int bj = 0; bj < 2; ++bj) { const int col = col0 + bj * 128;
                    const u32x4 yw = *(const u32x4*)(YS + row * 512 + col);
                    const float yv[8] = {bflo(yw.x), bfhi(yw.x), bflo(yw.y), bfhi(yw.y), bflo(yw.z), bfhi(yw.z), bflo(yw.w), bfhi(yw.w)};
                    float o[8];
#pragma unroll
                    for (int e = 0; e < 8; ++e) o[e] = yv[e] * sigmoidf_(acc[ai][bj][m][e >> 2][e & 3] + bg[col + e]);
                    u32x4 w; w.x = pk2(o[0], o[1]); w.y = pk2(o[2], o[3]); w.z = pk2(o[4], o[5]); w.w = pk2(o[6], o[7]);
                    *(u32x4*)(O + row * D + 1536 + col) = w; } }
    }
};

template <int MODE> __device__ __forceinline__ int src_col(int n_out, int coloff) {
    if (MODE == 0) return coloff + n_out;
    const int pn = n_out >> 8, c = n_out & 255, b = 2 * (c >> 7) + ((c >> 4) & 1), chl = 16 * ((c >> 5) & 3) + (c & 15);
    return coloff + b * 2048 + pn * 64 + chl;
}
template <int MODE> __device__ __forceinline__ void tr_item(const float* W, int ldsrc, int coloff, int K, bf16_t* WT, int row_off, int nblk, LAS float* scr, int item, int lane) {
    const int kb = item / nblk, nb = item % nblk, k0 = 64 * kb, n0 = 32 * nb;
    const int col = src_col<MODE>(n0 + (lane & 31), coloff);
#pragma unroll
    for (int i = 0; i < 32; ++i) { const int kk = 2 * i + (lane >> 5); scr[kk * 33 + (lane & 31)] = W[(size_t)(k0 + kk) * ldsrc + col]; }
    asm volatile("s_waitcnt lgkmcnt(0)" ::: "memory");
    const int c = lane & 7;
#pragma unroll
    for (int j = 0; j < 4; ++j) { const int n = (lane >> 3) + 8 * j; const LAS float* s = scr + (8 * c) * 33 + n;
        u32x4 o; o.x = pk2(s[0 * 33], s[1 * 33]); o.y = pk2(s[2 * 33], s[3 * 33]); o.z = pk2(s[4 * 33], s[5 * 33]); o.w = pk2(s[6 * 33], s[7 * 33]);
        *(u32x4*)(WT + (size_t)(row_off + n0 + n) * K + k0 + 8 * c) = o; }
    asm volatile("s_waitcnt lgkmcnt(0)" ::: "memory");
}
__device__ __forceinline__ void prologue_weights(tab_t in, unsigned char* ws, LAS unsigned char* lds, int gw, int NGW, int wave, int lane) {
    LAS float* scr = (LAS float*)(lds + wave * 16384);
    constexpr int I1 = 32 * 144, I2 = 32 * 256, I3 = 8 * 64, I4 = 32 * 64, I5 = 32 * 256, I6 = 128 * 64, I7 = 8 * 16;
    constexpr int PER = I1 + I2 + 4 * I3 + I4 + I5 + I6 + I7;
    for (int it = gw; it < DEPTH * PER; it += NGW) {
        const int l = it / PER; int r = it % PER;
        if (r < I1) { tr_item<0>(in[I_WIN] + (size_t)l * 2048 * 12800, 12800, 0, 2048, (bf16_t*)(ws + WS_WIN1) + (size_t)l * 4608 * 2048, 0, 144, scr, r, lane); continue; } r -= I1;
        if (r < I2) { tr_item<1>(in[I_WIN] + (size_t)l * 2048 * 12800, 12800, 4608, 2048, (bf16_t*)(ws + WS_WGATE) + (size_t)l * 8192 * 2048, 0, 256, scr, r, lane); continue; } r -= I2;
        if (r < 4 * I3) { const int b = r / I3; tr_item<0>(in[I_WBR] + (size_t)(l * 4 + b) * 512 * 2048, 2048, 0, 512, (bf16_t*)(ws + WS_WBR) + (size_t)l * 8192 * 512, b * 2048, 64, scr, r % I3, lane); continue; } r -= 4 * I3;
        if (r < I4) { tr_item<0>(in[I_WOUT] + (size_t)l * 2048 * 2048, 2048, 0, 2048, (bf16_t*)(ws + WS_WOUT) + (size_t)l * 2048 * 2048, 0, 64, scr, r, lane); continue; } r -= I4;
        if (r < I5) { tr_item<0>(in[I_WFF1] + (size_t)l * 2048 * 8192, 8192, 0, 2048, (bf16_t*)(ws + WS_WFF1) + (size_t)l * 8192 * 2048, 0, 256, scr, r, lane); continue; } r -= I5;
        if (r < I6) { tr_item<0>(in[I_WFF2] + (size_t)l * 8192 * 2048, 2048, 0, 8192, (bf16_t*)(ws + WS_WFF2) + (size_t)l * 2048 * 8192, 0, 64, scr, r, lane); continue; } r -= I6;
        tr_item<0>(in[I_SWGLU] + (size_t)l * 512 * 512, 512, 0, 512, (bf16_t*)(ws + WS_WGLU) + (size_t)l * 512 * 512, 0, 16, scr, r, lane);
    }
}
__device__ __forceinline__ void prologue_lru_w(tab_t in, unsigned char* ws, int gtid, int NT) {
    bf16_t* WL = (bf16_t*)(ws + WS_WLRU);
    for (int idx = gtid; idx < DEPTH * 2048 * 64; idx += NT) {
        const int kc = idx & 63, rr = (idx >> 6) & 2047, l = idx >> 17;
        const int pn = rr >> 8, d = pn >> 2, nb = pn & 3, c = rr & 255, gate = c >> 7, cc = c & 127;
        u32x4 o = (u32x4){0u, 0u, 0u, 0u};
        if ((kc >> 4) == nb) { const float* src = (gate ? in[I_LWX] : in[I_LWA]) + ((size_t)((l * 2 + d) * 4 + nb) * 128 + (kc & 15) * 8) * 128 + cc;
            o.x = pk2(src[0], src[128]); o.y = pk2(src[256], src[384]); o.z = pk2(src[512], src[640]); o.w = pk2(src[768], src[896]); }
        *(u32x4*)(WL + ((size_t)l * 2048 + rr) * 512 + kc * 8) = o;
    }
}
__device__ __forceinline__ void prologue_mod(tab_t in, unsigned char* ws, LAS unsigned char* lds, int bid, int G, int tid, int wave, int lane) {
    LAS float* sc = (LAS float*)lds;
    LAS float* red = (LAS float*)(lds + 73728);
    for (int i = tid; i < 9 * 2048; i += 512) { const int r = i >> 11, k = i & 2047; const float v = r == 0 ? in[I_CCTX][k] : in[I_C][(r - 1) * 2048 + k]; sc[i] = siluf_(v); }
    __syncthreads();
    float* MOD = (float*)(ws + WS_MOD);
    for (int it = bid; it < DEPTH * 192; it += G) {
        const int l = it / 192, cb = it % 192, col = cb * 64 + lane, kbase = wave * 256;
        const float* w = in[I_WMOD] + ((size_t)l * 2048 + kbase) * 12288 + col;
        float acc[9];
#pragma unroll
        for (int r = 0; r < 9; ++r) acc[r] = 0.f;
#pragma unroll 4
        for (int k = 0; k < 256; k += 4) {
            const float w0 = w[(size_t)k * 12288], w1 = w[(size_t)(k + 1) * 12288], w2 = w[(size_t)(k + 2) * 12288], w3 = w[(size_t)(k + 3) * 12288];
#pragma unroll
            for (int r = 0; r < 9; ++r) { const f32x4 s4 = *(const LAS f32x4*)(sc + r * 2048 + kbase + k); acc[r] += s4[0] * w0 + s4[1] * w1 + s4[2] * w2 + s4[3] * w3; }
        }
#pragma unroll
        for (int r = 0; r < 9; ++r) red[(wave * 9 + r) * 64 + lane] = acc[r];
        __syncthreads();
        for (int i = tid; i < 576; i += 512) { const int r = i >> 6, cl = i & 63; float s = in[I_BMOD][l * 12288 + cb * 64 + cl];
#pragma unroll
            for (int w8 = 0; w8 < 8; ++w8) s += red[(w8 * 9 + r) * 64 + cl];
            MOD[(size_t)(l * 9 + r) * 12288 + cb * 64 + cl] = s; }
        __syncthreads();
    }
}
__device__ __forceinline__ void cpow(float are, float aim, float dt, float tau, float& re, float& im) {
    const float mag = __expf(are * dt * tau); float rev = aim * dt * tau * 0.15915494309189535f; rev -= rintf(rev);
    re = mag * __builtin_amdgcn_cosf(rev); im = mag * __builtin_amdgcn_sinf(rev);
}
__device__ __forceinline__ void prologue_ssm(tab_t in, unsigned char* ws, LAS unsigned char* lds, int bid, int G, int tid) {
    LAS float* pw = (LAS float*)lds;
    LAS float* bb = pw + 2 * 17 * 64 * 2;
    LAS float* cc = bb + 2 * 64 * 16 * 2;
    LAS float* kf = cc + 2 * 16 * 64 * 2;
    LAS float* cf = kf + 2 * 16 * 256;
    for (int un = bid; un < DEPTH * 32; un += G) {
        const int l = un >> 5, g = un & 31;
        __syncthreads();
        if (tid < 128) { const int d = tid >> 6, p = tid & 63; const int ix = ((l * 2 + d) * 32 + g) * 64 + p;
            const float are = in[I_SARE][ix], aim = in[I_SAIM][ix], dt = __expf(in[I_SLDT][(l * 2 + d) * 32 + g]);
            for (int tau = 0; tau <= 16; ++tau) { float re, im; cpow(are, aim, dt, (float)tau, re, im); pw[((d * 17 + tau) * 64 + p) * 2] = re; pw[((d * 17 + tau) * 64 + p) * 2 + 1] = im;
                if (tau == 16) { float* A16 = (float*)(ws + WS_A16); A16[ix * 2] = re; A16[ix * 2 + 1] = im; }
                if (tau == 1) { const float zr = re - 1.0f, zi = im, den = 1.0f / (are * are + aim * aim); cf[(d * 64 + p) * 2] = (zr * are + zi * aim) * den; cf[(d * 64 + p) * 2 + 1] = (zi * are - zr * aim) * den; } }
        }
        __syncthreads();
        for (int i = tid; i < 2048; i += 512) { const int d = i >> 10, p = (i >> 4) & 63, c = i & 15;
            const size_t bix = ((size_t)((l * 2 + d) * 32 + g) * 64 + p) * 16 + c; const float br = in[I_SBRE][bix], bi = in[I_SBIM][bix], fr = cf[(d * 64 + p) * 2], fi = cf[(d * 64 + p) * 2 + 1];
            bb[i * 2] = fr * br - fi * bi; bb[i * 2 + 1] = fr * bi + fi * br;
            const int c2 = (i >> 6) & 15, p2 = i & 63; const size_t cix = ((size_t)((l * 2 + d) * 32 + g) * 16 + c2) * 64 + p2;
            cc[i * 2] = in[I_SCRE][cix]; cc[i * 2 + 1] = in[I_SCIM][cix]; }
        __syncthreads();
        for (int i = tid; i < 8192; i += 512) { const int d = i >> 12, tau = (i >> 8) & 15, c = (i >> 4) & 15, c2 = i & 15; float s = 0.f;
            for (int p = 0; p < 64; ++p) { const float cr = cc[((d * 16 + c) * 64 + p) * 2], ci = cc[((d * 16 + c) * 64 + p) * 2 + 1], ar = pw[((d * 17 + tau) * 64 + p) * 2], ai = pw[((d * 17 + tau) * 64 + p) * 2 + 1];
                const float wr = cr * ar - ci * ai, wi = cr * ai + ci * ar; s += wr * bb[((d * 64 + p) * 16 + c2) * 2] - wi * bb[((d * 64 + p) * 16 + c2) * 2 + 1]; }
            kf[i] = s; }
        __syncthreads();
        bf16_t* KM = (bf16_t*)(ws + WS_SSMK) + (size_t)(l * 32 + g) * 65536;
        bf16_t* CM = (bf16_t*)(ws + WS_SSMC) + (size_t)(l * 32 + g) * 65536;
        bf16_t* BMp = (bf16_t*)(ws + WS_SSMB) + (size_t)(l * 32 + g) * 65536;
        for (int i = tid; i < 32768; i += 512) {
            const int row = i >> 7, col = (i & 127) * 2;
            float v[2], w[2], z[2];
#pragma unroll
            for (int e = 0; e < 2; ++e) { const int cl = col + e;
                { const int t = row >> 4, c = row & 15, s = cl >> 4, c2 = cl & 15; float x = 0.f;
                  if (s <= t) x += kf[(0 * 16 + (t - s)) * 256 + c * 16 + c2];
                  if (s >= t) x += kf[(1 * 16 + (s - t)) * 256 + c * 16 + c2];
                  if (s == t && c == c2) x += in[I_SD][l * 512 + g * 16 + c];
                  v[e] = x; }
                { const int t = row >> 4, c = row & 15, d = cl >> 7, im = (cl >> 6) & 1, p = cl & 63, tau = d == 0 ? t + 1 : 16 - t;
                  const float cr = cc[((d * 16 + c) * 64 + p) * 2], ci = cc[((d * 16 + c) * 64 + p) * 2 + 1], ar = pw[((d * 17 + tau) * 64 + p) * 2], ai = pw[((d * 17 + tau) * 64 + p) * 2 + 1];
                  w[e] = im ? -(cr * ai + ci * ar) : (cr * ar - ci * ai); }
                { const int d = row >> 7, im = (row >> 6) & 1, p = row & 63, s = cl >> 4, c2 = cl & 15, tau = d == 0 ? 15 - s : s;
                  const float ar = pw[((d * 17 + tau) * 64 + p) * 2], ai = pw[((d * 17 + tau) * 64 + p) * 2 + 1], br = bb[((d * 64 + p) * 16 + c2) * 2], bi = bb[((d * 64 + p) * 16 + c2) * 2 + 1];
                  z[e] = im ? (ar * bi + ai * br) : (ar * br - ai * bi); } }
            *(unsigned*)(KM + (size_t)row * 256 + col) = pk2(v[0], v[1]);
            *(unsigned*)(CM + (size_t)row * 256 + col) = pk2(w[0], w[1]);
            *(unsigned*)(BMp + (size_t)row * 256 + col) = pk2(z[0], z[1]);
        }
    }
    __syncthreads();
}
__device__ __forceinline__ void norm_phase(const float* xp, const float* xs, float* X, bool first, const float* gain, const float* modl, int sh_idx, int sc_idx, bf16_t* H, int gw, int NGW, int lane) {
    for (int row = gw; row < MTOK; row += NGW) {
        const float* src = first ? (row < MCTX ? xp + (size_t)row * D : xs + (size_t)(row - MCTX) * D) : X + (size_t)row * D;
        f32x4 v[8]; float ss = 0.f;
#pragma unroll
        for (int j = 0; j < 8; ++j) { v[j] = *(const f32x4*)(src + 4 * (lane + 64 * j)); ss += (v[j][0] * v[j][0] + v[j][1] * v[j][1]) + (v[j][2] * v[j][2] + v[j][3] * v[j][3]); }
#pragma unroll
        for (int o = 1; o < 64; o <<= 1) ss += __shfl_xor(ss, o);
        const float rstd = rsqrtf(ss * (1.0f / D) + EPS);
        const int r = row < MCTX ? 0 : 1 + ((row - MCTX) >> 11);
        const float* mp = modl + (size_t)r * 12288;
#pragma unroll
        for (int j = 0; j < 8; ++j) { const int col = 4 * (lane + 64 * j);
            const f32x4 g4 = *(const f32x4*)(gain + col), sc4 = *(const f32x4*)(mp + sc_idx * 2048 + col), sh4 = *(const f32x4*)(mp + sh_idx * 2048 + col);
            const f32x4 y = v[j] * rstd * g4 * (sc4 + 1.0f) + sh4;
            u32x2 w; w.x = pk2(y[0], y[1]); w.y = pk2(y[2], y[3]); *(u32x2*)(H + (size_t)row * D + col) = w;
            if (first) *(f32x4*)(X + (size_t)row * D + col) = v[j]; }
    }
}

__device__ __forceinline__ void m1_attn_prep(bf16_t* PROJ, const float* qn, const float* kn, float* out, int l, int gtid, int NT) {
    for (int idx = gtid; idx < MTOK * 128; idx += NT) {
        const int part = idx & 15, hs = (idx >> 4) & 7, row = idx >> 7; const bool ctx = row < MCTX;
        if (hs >= 6 && !ctx) continue;
        const int col = (hs < 4 ? C_AQ + hs * 128 : hs < 6 ? C_AK + (hs - 4) * 128 : C_AV + (hs - 6) * 128) + part * 8;
        bf16_t* p = PROJ + (size_t)row * NPROJ + col;
        const u32x4 w = *(const u32x4*)p;
        float x[8] = {bflo(w.x), bfhi(w.x), bflo(w.y), bfhi(w.y), bflo(w.z), bfhi(w.z), bflo(w.w), bfhi(w.w)};
        if (hs >= 6) { float* o = out + O_NV + ((size_t)((row >> 8) * 4 + l) * 256 + (row & 255)) * 256 + (hs - 6) * 128 + part * 8;
            *(f32x4*)o = (f32x4){x[0], x[1], x[2], x[3]}; *(f32x4*)(o + 4) = (f32x4){x[4], x[5], x[6], x[7]}; continue; }
        float ss = 0.f;
#pragma unroll
        for (int e = 0; e < 8; ++e) ss += x[e] * x[e];
        ss += __shfl_xor(ss, 1); ss += __shfl_xor(ss, 2); ss += __shfl_xor(ss, 4); ss += __shfl_xor(ss, 8);
        const float rstd = rsqrtf(ss * (1.0f / 128.0f) + EPS);
        const float* gn = (hs < 4 ? qn : kn) + part * 8;
#pragma unroll
        for (int e = 0; e < 8; ++e) x[e] = x[e] * rstd * gn[e];
        if (ctx) { if (hs >= 4) { float* o = out + O_NK + ((size_t)((row >> 8) * 4 + l) * 256 + (row & 255)) * 256 + (hs - 4) * 128 + part * 8;
                *(f32x4*)o = (f32x4){x[0], x[1], x[2], x[3]}; *(f32x4*)(o + 4) = (f32x4){x[4], x[5], x[6], x[7]}; } }
        else { const int t = (row - MCTX) & 2047; const float rp = (float)(t >> 6), cp = (float)(t & 63);
#pragma unroll
            for (int e = 0; e < 8; ++e) { const float other = __shfl_xor(x[e], 8); const int i = (part & 7) * 8 + e; const float pos = i < 32 ? rp : cp;
                float rev = pos * __builtin_amdgcn_exp2f(-(float)(i & 31) * 0.41524101186092029f) * 0.15915494309189535f; rev -= rintf(rev);
                const float cs = __builtin_amdgcn_cosf(rev), sn = __builtin_amdgcn_sinf(rev);
                x[e] = part < 8 ? x[e] * cs - other * sn : x[e] * cs + other * sn; } }
        u32x4 o; o.x = pk2(x[0], x[1]); o.y = pk2(x[2], x[3]); o.z = pk2(x[4], x[5]); o.w = pk2(x[6], x[7]);
        *(u32x4*)p = o;
    }
}
__device__ __forceinline__ void m1_lru_conv(const bf16_t* PROJ, bf16_t* XC, const float* cw, const float* cb, int gtid, int NT) {
    for (int idx = gtid; idx < MTOK * 64; idx += NT) {
        const int row = idx >> 6, c8 = (idx & 63) * 8;
        const int t = row < MCTX ? (row & 255) : ((row - MCTX) & 2047), L = row < MCTX ? 256 : 2048;
        float a[8];
#pragma unroll
        for (int e = 0; e < 8; ++e) a[e] = cb[c8 + e];
#pragma unroll
        for (int j = 0; j < 4; ++j) { const int tt = t - 2 + j;
            if (tt >= 0 && tt < L) { const u32x4 w = *(const u32x4*)(PROJ + (size_t)(row - 2 + j) * NPROJ + C_LX + c8);
                const float x[8] = {bflo(w.x), bfhi(w.x), bflo(w.y), bfhi(w.y), bflo(w.z), bfhi(w.z), bflo(w.w), bfhi(w.w)};
#pragma unroll
                for (int e = 0; e < 8; ++e) a[e] += cw[j * 512 + c8 + e] * x[e]; } }
        u32x4 o; o.x = pk2(a[0], a[1]); o.y = pk2(a[2], a[3]); o.z = pk2(a[4], a[5]); o.w = pk2(a[6], a[7]);
        *(u32x4*)(XC + (size_t)row * 512 + c8) = o;
    }
}
__device__ __forceinline__ void m1_ssm_bu(const bf16_t* PROJ, const bf16_t* BMl, float* BU, int unit, int wave, int lane) {
    const int g = unit >> 3, bt0 = (unit & 7) * 12, fr = lane & 15, G4 = lane >> 4;
    const bf16_t* BMg = BMl + (size_t)g * 65536;
    bf16x8 af[2][8];
#pragma unroll
    for (int qi = 0; qi < 2; ++qi)
#pragma unroll
        for (int ks = 0; ks < 8; ++ks) af[qi][ks] = *(const bf16x8*)(BMg + (size_t)((2 * wave + qi) * 16 + fr) * 256 + ks * 32 + G4 * 8);
    for (int bt = bt0; bt < bt0 + 12; ++bt) {
        const int chunk = bt * 16 + fr;
        const bf16_t* up = PROJ + (size_t)(chunk * 16 + (G4 >> 1)) * NPROJ + C_SU + 16 * g + 8 * (G4 & 1);
        f32x4 acc[2] = {(f32x4){0.f, 0.f, 0.f, 0.f}, (f32x4){0.f, 0.f, 0.f, 0.f}};
#pragma unroll
        for (int ks = 0; ks < 8; ++ks) { const bf16x8 b = *(const bf16x8*)(up + (size_t)(2 * ks) * NPROJ);
            acc[0] = mfma16(af[0][ks], b, acc[0]); acc[1] = mfma16(af[1][ks], b, acc[1]); }
#pragma unroll
        for (int qi = 0; qi < 2; ++qi) *(f32x4*)(BU + ((size_t)g * NCHUNK16 + chunk) * 256 + (2 * wave + qi) * 16 + 4 * G4) = acc[qi];
    }
}
__device__ __forceinline__ float ret_log2gamma(float logit) { return -log1pf(__expf(-logit)) * LOG2E; }
__device__ __forceinline__ void m1_ret_kv(const bf16_t* PROJ, float* KV, const float* decl, LAS unsigned char* lds, int unit, int tid, int wave, int lane) {
    const int cn = unit >> 2, hh = unit & 3, fr = lane & 15, G4 = lane >> 4;
    LAS unsigned char* Ks = lds; LAS unsigned char* Vf = lds + 128 * 288; LAS unsigned char* Vb = lds + 2 * 128 * 288;
    const float lgf = ret_log2gamma(decl[hh]), lgb = ret_log2gamma(decl[4 + hh]);
    const size_t row0 = (size_t)cn * 128;
    __syncthreads();
    stage_rows<128>(Ks, 288, PROJ + row0 * NPROJ + C_RK + hh * 128, NPROJ, tid);
#pragma unroll
    for (int c = tid; c < 128 * 16; c += 512) { const int j = c >> 4, ch = c & 15; const u32x4 w = *(const u32x4*)(PROJ + (row0 + j) * NPROJ + C_RV + hh * 128 + ch * 8);
        const float wf = __builtin_amdgcn_exp2f((float)(127 - j) * lgf), wb = __builtin_amdgcn_exp2f((float)j * lgb);
        const float x[8] = {bflo(w.x), bfhi(w.x), bflo(w.y), bfhi(w.y), bflo(w.z), bfhi(w.z), bflo(w.w), bfhi(w.w)};
        u32x4 o; o.x = pk2(x[0] * wf, x[1] * wf); o.y = pk2(x[2] * wf, x[3] * wf); o.z = pk2(x[4] * wf, x[5] * wf); o.w = pk2(x[6] * wf, x[7] * wf);
        *(LAS u32x4*)(Vf + j * 288 + ch * 16) = o;
        o.x = pk2(x[0] * wb, x[1] * wb); o.y = pk2(x[2] * wb, x[3] * wb); o.z = pk2(x[4] * wb, x[5] * wb); o.w = pk2(x[6] * wb, x[7] * wb);
        *(LAS u32x4*)(Vb + j * 288 + ch * 16) = o; }
    __syncthreads();
    f32x4 af[8], ab[8];
#pragma unroll
    for (int nt = 0; nt < 8; ++nt) { af[nt] = (f32x4){0.f, 0.f, 0.f, 0.f}; ab[nt] = (f32x4){0.f, 0.f, 0.f, 0.f}; }
#pragma unroll
    for (int ks = 0; ks < 4; ++ks) {
        const bf16x8 a = frag_tr(Ks, 288, 32 * ks + 8 * G4, 32 * ks + 8 * G4 + 4, 16 * wave, lane);
#pragma unroll
        for (int nt = 0; nt < 8; ++nt) { const bf16x8 bf = frag_tr(Vf, 288, 32 * ks + 8 * G4, 32 * ks + 8 * G4 + 4, 16 * nt, lane), bb = frag_tr(Vb, 288, 32 * ks + 8 * G4, 32 * ks + 8 * G4 + 4, 16 * nt, lane);
            af[nt] = mfma16(a, bf, af[nt]); ab[nt] = mfma16(a, bb, ab[nt]); }
    }
    float* base = KV + (size_t)((cn * 4 + hh) * 2) * 16384;
#pragma unroll
    for (int nt = 0; nt < 8; ++nt) { *(f32x4*)(base + (size_t)(16 * nt + fr) * 128 + 16 * wave + 4 * G4) = af[nt]; *(f32x4*)(base + 16384 + (size_t)(16 * nt + fr) * 128 + 16 * wave + 4 * G4) = ab[nt]; }
}

__device__ __forceinline__ void m2_attn_unit(const bf16_t* PROJ, const float* ck, const float* cv, bf16_t* O, const float* sink, LAS unsigned char* lds, int u, int l, int tid, int wave, int lane) {
    const int fr = lane & 15, G4 = lane >> 4;
    const bool lat = u >= 256; int seq, kvh, qb; size_t rbase;
    if (!lat) { seq = u >> 3; kvh = (u >> 2) & 1; qb = u & 3; rbase = (size_t)seq * 256; }
    else { const int v = u - 256; seq = v >> 6; kvh = (v >> 5) & 1; qb = v & 31; rbase = (size_t)MCTX + (size_t)seq * 2048; }
    const int head = 2 * kvh + (wave >> 2), qq = (wave & 3) * 16 + fr;
    LAS unsigned char* Ks = lds; LAS unsigned char* Vs = lds + 64 * 272;
    bf16x8 qf[4];
    { const bf16_t* qp = PROJ + (rbase + qb * 64 + qq) * NPROJ + C_AQ + head * 128 + G4 * 8;
#pragma unroll
      for (int ks = 0; ks < 4; ++ks) qf[ks] = *(const bf16x8*)(qp + ks * 32); }
    float mrun = sink[head] * LOG2E, lsum = G4 == 0 ? 1.0f : 0.0f;
    f32x4 oacc[8];
#pragma unroll
    for (int mt = 0; mt < 8; ++mt) oacc[mt] = (f32x4){0.f, 0.f, 0.f, 0.f};
    const float SC2 = 0.08838834764831845f * LOG2E;
    const int ntile = lat ? 9 : 4;
    for (int it = 0; it < ntile; ++it) {
        int kind = 0, mask = 0; size_t krow0 = 0; int p0 = 0;
        if (!lat) krow0 = rbase + 64 * it;
        else if (it < 5) { const int tb = qb - 2 + it; if (tb < 0 || tb >= 32) continue; krow0 = rbase + 64 * tb; mask = it == 0 ? 1 : it == 4 ? 2 : 0; }
        else { kind = 1; p0 = 64 * (it - 5); }
        __syncthreads();
        if (kind == 0) { stage_rows<64>(Ks, 272, PROJ + krow0 * NPROJ + C_AK + kvh * 128, NPROJ, tid); stage_rows<64>(Vs, 288, PROJ + krow0 * NPROJ + C_AV + kvh * 128, NPROJ, tid); }
        else {
#pragma unroll
            for (int c = tid; c < 64 * 16; c += 512) { const int j = c >> 4, ch = c & 15; const size_t off = ((size_t)((seq * 4 + l) * 256 + p0 + j)) * 256 + kvh * 128 + ch * 8;
                const f32x4 k0 = *(const f32x4*)(ck + off), k1 = *(const f32x4*)(ck + off + 4), v0 = *(const f32x4*)(cv + off), v1 = *(const f32x4*)(cv + off + 4);
                u32x4 o; o.x = pk2(k0[0], k0[1]); o.y = pk2(k0[2], k0[3]); o.z = pk2(k1[0], k1[1]); o.w = pk2(k1[2], k1[3]); *(LAS u32x4*)(Ks + j * 272 + ch * 16) = o;
                o.x = pk2(v0[0], v0[1]); o.y = pk2(v0[2], v0[3]); o.z = pk2(v1[0], v1[1]); o.w = pk2(v1[2], v1[3]); *(LAS u32x4*)(Vs + j * 288 + ch * 16) = o; } }
        __syncthreads();
        f32x4 sa[4];
#pragma unroll
        for (int nt = 0; nt < 4; ++nt) { sa[nt] = (f32x4){0.f, 0.f, 0.f, 0.f};
#pragma unroll
            for (int ks = 0; ks < 4; ++ks) sa[nt] = mfma16(*(const LAS bf16x8*)(Ks + (nt * 16 + fr) * 272 + (ks * 32 + G4 * 8) * 2), qf[ks], sa[nt]); }
        float tmax = -3.0e38f;
#pragma unroll
        for (int nt = 0; nt < 4; ++nt)
#pragma unroll
            for (int r = 0; r < 4; ++r) { const int jj = 16 * nt + 4 * G4 + r; float s = sa[nt][r] * SC2;
                if (mask == 1 && jj < qq) s = -3.0e38f; if (mask == 2 && jj > qq) s = -3.0e38f; sa[nt][r] = s; tmax = fmaxf(tmax, s); }
        tmax = fmaxf(tmax, __shfl_xor(tmax, 16)); tmax = fmaxf(tmax, __shfl_xor(tmax, 32));
        const float mnew = fmaxf(mrun, tmax), alpha = __builtin_amdgcn_exp2f(mrun - mnew); mrun = mnew;
        float ps = 0.f;
#pragma unroll
        for (int nt = 0; nt < 4; ++nt)
#pragma unroll
            for (int r = 0; r < 4; ++r) { const float p = __builtin_amdgcn_exp2f(sa[nt][r] - mnew); sa[nt][r] = p; ps += p; }
        lsum = lsum * alpha + ps;
        const bf16x8 pf0 = pack8(sa[0], sa[1]), pf1 = pack8(sa[2], sa[3]);
#pragma unroll
        for (int mt = 0; mt < 8; ++mt) { oacc[mt] = oacc[mt] * alpha;
            oacc[mt] = mfma16(frag_tr(Vs, 288, 4 * G4, 16 + 4 * G4, 16 * mt, lane), pf0, oacc[mt]);
            oacc[mt] = mfma16(frag_tr(Vs, 288, 32 + 4 * G4, 48 + 4 * G4, 16 * mt, lane), pf1, oacc[mt]); }
    }
    lsum += __shfl_xor(lsum, 16); lsum += __shfl_xor(lsum, 32);
    const float inv = 1.0f / lsum;
    bf16_t* op = O + (rbase + qb * 64 + qq) * D + 1024 + head * 128 + 4 * G4;
#pragma unroll
    for (int mt = 0; mt < 8; ++mt) { u32x2 w; w.x = pk2(oacc[mt][0] * inv, oacc[mt][1] * inv); w.y = pk2(oacc[mt][2] * inv, oacc[mt][3] * inv); *(u32x2*)(op + 16 * mt) = w; }
}
__device__ __forceinline__ void m2_ssm_scan(const float* BU, bf16_t* HS, const float* A16l, const float* sre, const float* sim, float* out, int l, int item, int tid) {
    const int seq = item >> 3, g = (item & 7) * 4 + (tid >> 7), c = tid & 127, dir = c >> 6, p = c & 63;
    const bool lat = seq >= 32; const int chunk0 = lat ? 512 + (seq - 32) * 128 : seq * 16, N = lat ? 128 : 16;
    const float ar = A16l[((dir * 32 + g) * 64 + p) * 2], ai = A16l[((dir * 32 + g) * 64 + p) * 2 + 1];
    float hr = 0.f, hi = 0.f;
    if (lat) { const size_t ix = ((size_t)(((seq - 32) * 4 + l) * 2 + dir) * 32 + g) * 64 + p; hr = sre[ix]; hi = sim[ix]; }
    const long step = dir == 0 ? 1 : -1; const int cfirst = chunk0 + (dir == 0 ? 0 : N - 1);
    const float* bp = BU + ((size_t)g * NCHUNK16 + cfirst) * 256 + dir * 128 + p;
    bf16_t* hp = HS + ((size_t)cfirst * 32 + g) * 256 + dir * 128 + p;
    for (int s0 = 0; s0 < N; s0 += 16) {
        float br[16], bi[16];
#pragma unroll
        for (int k = 0; k < 16; ++k) { br[k] = bp[(long)(s0 + k) * step * 256]; bi[k] = bp[(long)(s0 + k) * step * 256 + 64]; }
#pragma unroll
        for (int k = 0; k < 16; ++k) { bf16_t* h2 = hp + (long)(s0 + k) * step * 8192; h2[0] = (bf16_t)(pk2(hr, 0.f) & 0xffffu); h2[64] = (bf16_t)(pk2(hi, 0.f) & 0xffffu);
            const float nr = ar * hr - ai * hi + br[k], ni = ar * hi + ai * hr + bi[k]; hr = nr; hi = ni; }
    }
    if (!lat) { const size_t ix = ((size_t)((seq * 4 + l) * 2 + dir) * 32 + g) * 64 + p; out[O_NSRE + ix] = hr; out[O_NSIM + ix] = hi; }
}
template <int N> __device__ __forceinline__ f32x4 ret_scan_run(const float* KV, bf16_t* SIN, f32x4 S, float g128, int c0, int dir, size_t inner) {
    f32x4 kv[N];
#pragma unroll
    for (int st = 0; st < N; ++st) { const int cn = c0 + (dir == 0 ? st : N - 1 - st); kv[st] = *(const f32x4*)(KV + (size_t)cn * 131072 + inner); }
#pragma unroll
    for (int st = 0; st < N; ++st) { const int cn = c0 + (dir == 0 ? st : N - 1 - st); u32x2 w; w.x = pk2(S[0], S[1]); w.y = pk2(S[2], S[3]); *(u32x2*)(SIN + (size_t)cn * 131072 + inner) = w; S = S * g128 + kv[st]; }
    return S;
}
__device__ __forceinline__ void m2_ret_scan(const float* KV, bf16_t* SIN, const float* sret, const float* decl, float* out, int l, int gtid, int NT) {
    for (int idx = gtid; idx < 40 * 4 * 2 * 128 * 32; idx += NT) {
        const int dk4 = (idx & 31) * 4, dv = (idx >> 5) & 127, dir = (idx >> 12) & 1, hh = (idx >> 13) & 3, seq = idx >> 15;
        const bool lat = seq >= 32; const int c0 = lat ? 64 + (seq - 32) * 16 : seq * 2;
        const float g128 = __builtin_amdgcn_exp2f(128.0f * ret_log2gamma(decl[dir * 4 + hh]));
        const size_t inner = (size_t)(hh * 2 + dir) * 16384 + (size_t)dv * 128 + dk4;
        f32x4 S = (f32x4){0.f, 0.f, 0.f, 0.f};
        if (lat) { const float* sp = sret + ((size_t)((((seq - 32) * 4 + l) * 2 + dir) * 4 + hh) * 128 + dk4) * 128 + dv; S = (f32x4){sp[0], sp[128], sp[256], sp[384]};
            S = ret_scan_run<16>(KV, SIN, S, g128, c0, dir, inner); }
        else { S = ret_scan_run<2>(KV, SIN, S, g128, c0, dir, inner);
            float* op = out + O_NRET + ((size_t)(((seq * 4 + l) * 2 + dir) * 4 + hh) * 128 + dk4) * 128 + dv; op[0] = S[0]; op[128] = S[1]; op[256] = S[2]; op[384] = S[3]; }
    }
}

template <int T> __device__ __forceinline__ void lru_task(const bf16_t* LA, const bf16_t* LB, const bf16_t* PROJ, bf16_t* O, const float* slru, float* out, LAS unsigned char* lds, int l, bool lat, int seq, int cg, size_t rbase, int tid, int wave, int lane) {
    constexpr int TB = T < 16 ? T : 16;
    const int chl = lane & 15, seg = wave * 4 + (lane >> 4), ch = cg * 16 + chl;
    LAS float* sA = (LAS float*)lds;
    LAS float* sH = sA + 1024;
    LAS float* hl = (LAS float*)(lds + 8192) + tid;
    const bf16_t* pa = LA + (rbase + (size_t)seg * T) * 1024 + ch; const bf16_t* pb = LB + (rbase + (size_t)seg * T) * 1024 + ch;
    float As = 0.f, hf = 0.f, Ab = 0.f, hb = 0.f;
#pragma unroll 1
    for (int t0 = 0; t0 < T; t0 += TB) { unsigned short ra[TB], rb[TB]; const bf16_t* qa = pa + (size_t)t0 * 1024; const bf16_t* qb = pb + (size_t)t0 * 1024;
#pragma unroll
        for (int k = 0; k < TB; ++k) { ra[k] = qa[k * 1024]; rb[k] = qb[k * 1024]; }
#pragma unroll
        for (int k = 0; k < TB; ++k) { const float la = bf2f(ra[k]); hf = __builtin_amdgcn_exp2f(la) * hf + bf2f(rb[k]); As += la; } }
#pragma unroll 1
    for (int t0 = T - TB; t0 >= 0; t0 -= TB) { unsigned short ra[TB], rb[TB]; const bf16_t* qa = pa + (size_t)t0 * 1024 + 512; const bf16_t* qb = pb + (size_t)t0 * 1024 + 512;
#pragma unroll
        for (int k = 0; k < TB; ++k) { ra[k] = qa[k * 1024]; rb[k] = qb[k * 1024]; }
#pragma unroll
        for (int k = TB - 1; k >= 0; --k) { const float la = bf2f(ra[k]); hb = __builtin_amdgcn_exp2f(la) * hb + bf2f(rb[k]); Ab += la; } }
    __syncthreads();
    sA[seg * 16 + chl] = As; sH[seg * 16 + chl] = hf; sA[512 + seg * 16 + chl] = Ab; sH[512 + seg * 16 + chl] = hb;
    __syncthreads();
    float hinf = 0.f, hinb = 0.f;
    if (lat) { hinf = slru[(size_t)(((seq - 32) * 4 + l) * 2 + 0) * 512 + ch]; hinb = slru[(size_t)(((seq - 32) * 4 + l) * 2 + 1) * 512 + ch]; }
    for (int s = 0; s < seg; ++s) hinf = __builtin_amdgcn_exp2f(sA[s * 16 + chl]) * hinf + sH[s * 16 + chl];
    for (int s = 31; s > seg; --s) hinb = __builtin_amdgcn_exp2f(sA[512 + s * 16 + chl]) * hinb + sH[512 + s * 16 + chl];
    float h = hinf;
#pragma unroll 1
    for (int t0 = 0; t0 < T; t0 += TB) { unsigned short ra[TB], rb[TB]; const bf16_t* qa = pa + (size_t)t0 * 1024; const bf16_t* qb = pb + (size_t)t0 * 1024;
#pragma unroll
        for (int k = 0; k < TB; ++k) { ra[k] = qa[k * 1024]; rb[k] = qb[k * 1024]; }
#pragma unroll
        for (int k = 0; k < TB; ++k) { h = __builtin_amdgcn_exp2f(bf2f(ra[k])) * h + bf2f(rb[k]); hl[(t0 + k) * 512] = h; } }
    if (!lat && seg == 31) out[O_NLRU + (size_t)((seq * 4 + l) * 2 + 0) * 512 + ch] = h;
    h = hinb;
    const bf16_t* pg = PROJ + (rbase + (size_t)seg * T) * NPROJ + C_LG + ch; bf16_t* po = O + (rbase + (size_t)seg * T) * D + 512 + ch;
#pragma unroll 1
    for (int t0 = T - TB; t0 >= 0; t0 -= TB) { unsigned short ra[TB], rb[TB], rg[TB]; const bf16_t* qa = pa + (size_t)t0 * 1024 + 512; const bf16_t* qb = pb + (size_t)t0 * 1024 + 512; const bf16_t* qg = pg + (size_t)t0 * NPROJ; bf16_t* qo = po + (size_t)t0 * D;
#pragma unroll
        for (int k = 0; k < TB; ++k) { ra[k] = qa[k * 1024]; rb[k] = qb[k * 1024]; rg[k] = qg[k * NPROJ]; }
#pragma unroll
        for (int k = TB - 1; k >= 0; --k) { h = __builtin_amdgcn_exp2f(bf2f(ra[k])) * h + bf2f(rb[k]);
            const float y = gelu_tanh(bf2f(rg[k])) * (hl[(t0 + k) * 512] + h); qo[k * D] = (bf16_t)(pk2(y, 0.f) & 0xffffu); } }
    if (!lat && seg == 0) out[O_NLRU + (size_t)((seq * 4 + l) * 2 + 1) * 512 + ch] = h;
}
__device__ __forceinline__ void m3_lru_scan(const bf16_t* LA, const bf16_t* LB, const bf16_t* PROJ, bf16_t* O, const float* slru, float* out, LAS unsigned char* lds, int l, int task, int tid, int wave, int lane) {
    if (task < 256) { const int seq = 32 + (task >> 5); lru_task<64>(LA, LB, PROJ, O, slru, out, lds, l, true, seq, task & 31, (size_t)MCTX + (size_t)(seq - 32) * 2048, tid, wave, lane); }
    else { const int t2 = task - 256, seq = t2 >> 5; lru_task<8>(LA, LB, PROJ, O, slru, out, lds, l, false, seq, t2 & 31, (size_t)seq * 256, tid, wave, lane); }
}
__device__ __forceinline__ void m3_ssm_y(const bf16_t* PROJ, const bf16_t* KMl, const bf16_t* CMl, const bf16_t* HS, bf16_t* YS, int unit, int wave, int lane) {
    const int g = unit >> 3, bt0 = (unit & 7) * 12, fr = lane & 15, G4 = lane >> 4;
    const bf16_t* KMg = KMl + (size_t)g * 65536; const bf16_t* CMg = CMl + (size_t)g * 65536;
    bf16x8 kf[2][8], cf[2][8];
#pragma unroll
    for (int qi = 0; qi < 2; ++qi)
#pragma unroll
        for (int ks = 0; ks < 8; ++ks) { kf[qi][ks] = *(const bf16x8*)(KMg + (size_t)((2 * wave + qi) * 16 + fr) * 256 + ks * 32 + G4 * 8); cf[qi][ks] = *(const bf16x8*)(CMg + (size_t)((2 * wave + qi) * 16 + fr) * 256 + ks * 32 + G4 * 8); }
    for (int bt = bt0; bt < bt0 + 12; ++bt) {
        const int chunk = bt * 16 + fr;
        const bf16_t* up = PROJ + (size_t)(chunk * 16 + (G4 >> 1)) * NPROJ + C_SU + 16 * g + 8 * (G4 & 1);
        const bf16_t* hp = HS + ((size_t)chunk * 32 + g) * 256 + G4 * 8;
        f32x4 acc[2] = {(f32x4){0.f, 0.f, 0.f, 0.f}, (f32x4){0.f, 0.f, 0.f, 0.f}};
#pragma unroll
        for (int ks = 0; ks < 8; ++ks) { const bf16x8 bu = *(const bf16x8*)(up + (size_t)(2 * ks) * NPROJ), bh = *(const bf16x8*)(hp + ks * 32);
            acc[0] = mfma16(kf[0][ks], bu, acc[0]); acc[1] = mfma16(kf[1][ks], bu, acc[1]); acc[0] = mfma16(cf[0][ks], bh, acc[0]); acc[1] = mfma16(cf[1][ks], bh, acc[1]); }
#pragma unroll
        for (int qi = 0; qi < 2; ++qi) { const int t = 2 * wave + qi; u32x2 w; w.x = pk2(gelu_tanh(acc[qi][0]), gelu_tanh(acc[qi][1])); w.y = pk2(gelu_tanh(acc[qi][2]), gelu_tanh(acc[qi][3]));
            *(u32x2*)(YS + (size_t)(chunk * 16 + t) * 512 + g * 16 + 4 * G4) = w; }
    }
}
__device__ __forceinline__ void m3_ret_out(const bf16_t* PROJ, const bf16_t* SIN, bf16_t* O, const float* decl, const float* gnl, LAS unsigned char* lds, int unit, int tid, int wave, int lane) {
    const int cn = unit >> 2, hh = unit & 3, fr = lane & 15, G4 = lane >> 4;
    LAS unsigned char* Ks = lds; LAS unsigned char* Vs = lds + 128 * 272;
    const size_t row0 = (size_t)cn * 128;
    const float lgf = ret_log2gamma(decl[hh]), lgb = ret_log2gamma(decl[4 + hh]), scale = 0.08838834764831845f;
    __syncthreads();
    stage_rows<128>(Ks, 272, PROJ + row0 * NPROJ + C_RK + hh * 128, NPROJ, tid);
    stage_rows<128>(Vs, 288, PROJ + row0 * NPROJ + C_RV + hh * 128, NPROJ, tid);
    const int i = wave * 16 + fr;
    bf16x8 qf[4];
    { const bf16_t* qp = PROJ + (row0 + i) * NPROJ + C_RQ + hh * 128 + G4 * 8;
#pragma unroll
      for (int ks = 0; ks < 4; ++ks) qf[ks] = *(const bf16x8*)(qp + ks * 32); }
    __syncthreads();
    bf16x8 pf[4];
    {   f32x4 sa[8];
#pragma unroll
        for (int jt = 0; jt < 8; ++jt) { sa[jt] = (f32x4){0.f, 0.f, 0.f, 0.f};
#pragma unroll
            for (int ks = 0; ks < 4; ++ks) sa[jt] = mfma16(*(const LAS bf16x8*)(Ks + (jt * 16 + fr) * 272 + (ks * 32 + G4 * 8) * 2), qf[ks], sa[jt]); }
#pragma unroll
        for (int jt = 0; jt < 8; ++jt)
#pragma unroll
            for (int r = 0; r < 4; ++r) { const int dlt = i - (16 * jt + 4 * G4 + r); float f = 0.f;
                if (dlt >= 0) f += __builtin_amdgcn_exp2f((float)dlt * lgf); if (dlt <= 0) f += __builtin_amdgcn_exp2f((float)(-dlt) * lgb); sa[jt][r] *= f * scale; }
#pragma unroll
        for (int s = 0; s < 4; ++s) pf[s] = pack8(sa[2 * s], sa[2 * s + 1]);
    }
    const float wfi = __builtin_amdgcn_exp2f((float)(i + 1) * lgf) * scale, wbi = __builtin_amdgcn_exp2f((float)(128 - i) * lgb) * scale;
    const bf16_t* Sf = SIN + (size_t)((cn * 4 + hh) * 2) * 16384 + (size_t)fr * 128 + G4 * 8; const bf16_t* Sb = Sf + 16384;
    f32x4 o[8]; float sum = 0.f;
#pragma unroll
    for (int mt = 0; mt < 8; ++mt) {
        f32x4 oi = (f32x4){0.f, 0.f, 0.f, 0.f}, of = oi, ob = oi;
#pragma unroll
        for (int s = 0; s < 4; ++s) { oi = mfma16(frag_tr(Vs, 288, 32 * s + 4 * G4, 32 * s + 16 + 4 * G4, 16 * mt, lane), pf[s], oi);
            of = mfma16(*(const bf16x8*)(Sf + (size_t)mt * 2048 + s * 32), qf[s], of); ob = mfma16(*(const bf16x8*)(Sb + (size_t)mt * 2048 + s * 32), qf[s], ob); }
        o[mt] = oi + of * wfi + ob * wbi; sum += (o[mt][0] + o[mt][1]) + (o[mt][2] + o[mt][3]);
    }
    sum += __shfl_xor(sum, 16); sum += __shfl_xor(sum, 32);
    const float mu = sum * (1.0f / 128.0f); float q = 0.f;
#pragma unroll
    for (int mt = 0; mt < 8; ++mt) { o[mt] = o[mt] - mu; q += (o[mt][0] * o[mt][0] + o[mt][1] * o[mt][1]) + (o[mt][2] * o[mt][2] + o[mt][3] * o[mt][3]); }
    q += __shfl_xor(q, 16); q += __shfl_xor(q, 32);
    const float rstd = rsqrtf(q * (1.0f / 128.0f) + EPS);
#pragma unroll
    for (int mt = 0; mt < 8; ++mt) { const int dv0 = 16 * mt + 4 * G4; const f32x4 gn4 = *(const f32x4*)(gnl + hh * 128 + dv0);
        const u32x2 gw = *(const u32x2*)(PROJ + (row0 + i) * NPROJ + C_RG + hh * 128 + dv0);
        const float g0 = siluf_(bflo(gw.x)), g1 = siluf_(bfhi(gw.x)), g2 = siluf_(bflo(gw.y)), g3 = siluf_(bfhi(gw.y));
        u32x2 w; w.x = pk2(o[mt][0] * rstd * gn4[0] * g0, o[mt][1] * rstd * gn4[1] * g1); w.y = pk2(o[mt][2] * rstd * gn4[2] * g2, o[mt][3] * rstd * gn4[3] * g3);
        *(u32x2*)(O + (row0 + i) * D + hh * 128 + dv0) = w; }
}
#ifndef REP_PRO
#define REP_PRO 1
#endif
#ifndef REP_NORM1
#define REP_NORM1 1
#endif
#ifndef REP_GIN
#define REP_GIN 1
#endif
#ifndef REP_M1
#define REP_M1 1
#endif
#ifndef REP_M2
#define REP_M2 1
#endif
#ifndef REP_M3
#define REP_M3 1
#endif
#ifndef REP_M4
#define REP_M4 1
#endif
#ifndef REP_GP
#define REP_GP 1
#endif
#ifndef REP_GG
#define REP_GG 1
#endif
#ifndef REP_GO
#define REP_GO 1
#endif
#ifndef REP_NORM2
#define REP_NORM2 1
#endif
#ifndef REP_FF1
#define REP_FF1 1
#endif
#ifndef REP_FF2
#define REP_FF2 1
#endif
#ifndef PH_PRO
#define PH_PRO 1
#endif
#ifndef PH_NORM1
#define PH_NORM1 1
#endif
#ifndef PH_GIN
#define PH_GIN 1
#endif
#ifndef PH_M1
#define PH_M1 1
#endif
#ifndef PH_M2
#define PH_M2 1
#endif
#ifndef PH_M3
#define PH_M3 1
#endif
#ifndef PH_M4
#define PH_M4 1
#endif
#ifndef PH_GP
#define PH_GP 1
#endif
#ifndef PH_GG
#define PH_GG 1
#endif
#ifndef PH_GO
#define PH_GO 1
#endif
#ifndef PH_NORM2
#define PH_NORM2 1
#endif
#ifndef PH_FFN
#define PH_FFN 1
#endif

struct Args { const float* in[N_IN]; float* out; unsigned char* ws; };
__global__ void __launch_bounds__(512, 2) fwd_kernel(Args a) {
    extern __shared__ __attribute__((aligned(16))) unsigned char lds_raw[];
    LAS unsigned char* lds = (LAS unsigned char*)lds_raw;
    int tid = threadIdx.x; const int bid = blockIdx.x, G = gridDim.x, NT = G * 512, NGW = G * 8;
    int lane, wave, gtid, gw;
#define REIDX() do { tid = threadIdx.x; asm volatile("" : "+v"(tid)); lane = tid & 63; wave = __builtin_amdgcn_readfirstlane(tid >> 6); gtid = bid * 512 + tid; gw = bid * 8 + wave; } while (0)
    REIDX();
    unsigned char* ws = (unsigned char*)in_tab()[N_IN + 1]; float* out = (float*)in_tab()[N_IN];
    if (tid < 4) ((LAS unsigned*)(lds + LDS_MISC))[tid] = 0u;
    __syncthreads();
    XcdBarrier bar = xcd_barrier_post((unsigned*)(ws + WS_CTL) + CW_BAR, (volatile LAS unsigned*)(lds + LDS_MISC));
#define GRID_BAR() do { XcdBarrier b2_ = bar; asm volatile("" : "+s"(b2_.x)); xcd_barrier(b2_); } while (0)
    float* MOD = (float*)(ws + WS_MOD);
    bf16_t* H = (bf16_t*)(ws + WS_H); bf16_t* PROJ = (bf16_t*)(ws + WS_PROJ); bf16_t* OB = (bf16_t*)(ws + WS_O); bf16_t* PB = (bf16_t*)(ws + WS_P); bf16_t* MG = (bf16_t*)(ws + WS_MG);
    bf16_t* XC = (bf16_t*)(ws + WS_XC); bf16_t* LA = (bf16_t*)(ws + WS_LA); bf16_t* LB = (bf16_t*)(ws + WS_LB); float* HF = (float*)(ws + WS_HF); bf16_t* YS = (bf16_t*)(ws + WS_YS);
    float* BU = (float*)(ws + WS_BU); bf16_t* HS = (bf16_t*)(ws + WS_HS); float* KV = (float*)(ws + WS_KV); bf16_t* SIN = (bf16_t*)(ws + WS_SIN);
    float* X = out;

#if PH_PRO
    for (int rep = 0; rep < REP_PRO; ++rep) {
    REIDX();
    prologue_weights(in_tab(), ws, lds, gw, NGW, wave, lane);
    prologue_lru_w(in_tab(), ws, gtid, NT);
    __syncthreads();
    prologue_mod(in_tab(), ws, lds, bid, G, tid, wave, lane);
    prologue_ssm(in_tab(), ws, lds, (bid + 128) % G, G, tid);
    }
#endif
    GRID_BAR();

    for (int l = 0; l < DEPTH; ++l) {
        const float* modl = MOD + (size_t)l * 9 * 12288;
#if PH_NORM1
        for (int rep = 0; rep < REP_NORM1; ++rep) {
        REIDX();
        norm_phase(INP(I_XP), INP(I_XS), X, l == 0, INP(I_NORM1) + l * D, modl, 0, 1, H, gw, NGW, lane);
        }
#endif
        GRID_BAR();
#if PH_GIN
        for (int rep = 0; rep < REP_GIN; ++rep) {
        REIDX();
        { pg8::Gemm g{H, (const bf16_t*)(ws + WS_WIN1) + (size_t)l * NPROJ * D, MTOK, NPROJ, D, D, D, 1 << 20, 0}; pg8::StaticOrder S; S.init(MTOK, NPROJ, G, bid);
          EpiStore E{PROJ, NPROJ, 0}; pg8::gemm_phase<EpiStore>(lds, g, S, E); }
        }
#endif
        GRID_BAR();
#if PH_M1
        REIDX();
        m1_attn_prep(PROJ, INP(I_QN) + l * 128, INP(I_KN) + l * 128, out, l, gtid, NT);
        for (int rep = 0; rep < REP_M1; ++rep) {
        REIDX();
        m1_lru_conv(PROJ, XC, INP(I_LCW) + l * 4 * 512, INP(I_LCB) + l * 512, gtid, NT);
        for (int u = bid; u < 256; u += G) m1_ssm_bu(PROJ, (const bf16_t*)(ws + WS_SSMB) + (size_t)l * 32 * 65536, BU, u, wave, lane);
        for (int u = bid; u < NCHUNK128 * 4; u += G) m1_ret_kv(PROJ, KV, INP(I_RDEC) + l * 8, lds, u, tid, wave, lane);
        }
#endif
        GRID_BAR();
#if PH_M2
        for (int rep = 0; rep < REP_M2; ++rep) {
        REIDX();
        { pg8::Gemm g{XC, (const bf16_t*)(ws + WS_WLRU) + (size_t)l * 2048 * 512, MTOK, 2048, 512, 512, 512, 1 << 20, 0}; pg8::StaticOrder S; S.init(MTOK, 2048, G, bid);
          EpiLru E{XC, LA, LB, INP(I_LBA) + l * 1024, INP(I_LBX) + l * 1024, INP(I_LLAM) + l * 1024}; pg8::gemm_phase<EpiLru>(lds, g, S, E); }
        for (int u = bid; u < 768; u += G) m2_attn_unit(PROJ, INP(I_CK), INP(I_CV), OB, INP(I_SINK) + l * 4, lds, u, l, tid, wave, lane);
        for (int it = bid; it < 320; it += G) m2_ssm_scan(BU, HS, (const float*)(ws + WS_A16) + (size_t)l * 2 * 32 * 64 * 2, INP(I_SSRE), INP(I_SSIM), out, l, it, tid);
        m2_ret_scan(KV, SIN, INP(I_SRET), INP(I_RDEC) + l * 8, out, l, gtid, NT);
        }
#endif
        GRID_BAR();
#if PH_M3
        for (int rep = 0; rep < REP_M3; ++rep) {
        REIDX();
        for (int t = bid; t < 1280; t += G) m3_lru_scan(LA, LB, PROJ, OB, INP(I_SLRU), out, lds, l, t, tid, wave, lane);
        for (int u = bid; u < 256; u += G) m3_ssm_y(PROJ, (const bf16_t*)(ws + WS_SSMK) + (size_t)l * 32 * 65536, (const bf16_t*)(ws + WS_SSMC) + (size_t)l * 32 * 65536, HS, YS, u, wave, lane);
        for (int u = bid; u < NCHUNK128 * 4; u += G) m3_ret_out(PROJ, SIN, OB, INP(I_RDEC) + l * 8, INP(I_RGN) + l * 512, lds, u, tid, wave, lane);
        }
#endif
        GRID_BAR();
#if PH_M4
        for (int rep = 0; rep < REP_M4; ++rep) {
        REIDX();
        { pg8::Gemm g{YS, (const bf16_t*)(ws + WS_WGLU) + (size_t)l * 512 * 512, MTOK, 512, 512, 512, 512, 1 << 20, 0}; pg8::StaticOrder S; S.init(MTOK, 512, G, bid);
          EpiGlu E{YS, OB, INP(I_SBGLU) + l * 512}; pg8::gemm_phase<EpiGlu>(lds, g, S, E); }
        }
#endif
        GRID_BAR();
#if PH_GP
        for (int rep = 0; rep < REP_GP; ++rep) {
        REIDX();
        { pg8::Gemm g{OB, (const bf16_t*)(ws + WS_WBR) + (size_t)l * 8192 * 512, MTOK, 8192, 512, D, 512, 8, 512}; pg8::StaticOrder S; S.init(MTOK, 8192, G, bid);
          EpiStore E{PB, 8192, 0}; pg8::gemm_phase<EpiStore>(lds, g, S, E); }
        }
#endif
        GRID_BAR();
#if PH_GG
        for (int rep = 0; rep < REP_GG; ++rep) {
        REIDX();
        { pg8::Gemm g{H, (const bf16_t*)(ws + WS_WGATE) + (size_t)l * 8192 * D, MTOK, 8192, D, D, D, 1 << 20, 0}; pg8::StaticOrder S; S.init(MTOK, 8192, G, bid);
          EpiGate E{PB, MG}; pg8::gemm_phase<EpiGate>(lds, g, S, E); }
        }
#endif
        GRID_BAR();
#if PH_GO
        for (int rep = 0; rep < REP_GO; ++rep) {
        REIDX();
        { pg8::Gemm g{MG, (const bf16_t*)(ws + WS_WOUT) + (size_t)l * D * D, MTOK, D, D, D, D, 1 << 20, 0}; pg8::StaticOrder S; S.init(MTOK, D, G, bid);
          EpiResid E{X, rep == REP_GO - 1 ? X : (float*)PB, modl + 2 * 2048}; pg8::gemm_phase<EpiResid>(lds, g, S, E); }
        }
#endif
        GRID_BAR();
#if PH_NORM2
        for (int rep = 0; rep < REP_NORM2; ++rep) {
        REIDX();
        norm_phase(nullptr, nullptr, X, false, INP(I_NORM2) + l * D, modl, 3, 4, H, gw, NGW, lane);
        }
#endif
        GRID_BAR();
#if PH_FFN
        for (int rep = 0; rep < REP_FF1; ++rep) {
        REIDX();
        { pg8::Gemm g{H, (const bf16_t*)(ws + WS_WFF1) + (size_t)l * DFF * D, MTOK, DFF, D, D, D, 1 << 20, 0}; pg8::StaticOrder S; S.init(MTOK, DFF, G, bid);
          EpiStore E{PB, DFF, 1}; pg8::gemm_phase<EpiStore>(lds, g, S, E); }
        }
        GRID_BAR();
        for (int rep = 0; rep < REP_FF2; ++rep) {
        REIDX();
        { pg8::Gemm g{PB, (const bf16_t*)(ws + WS_WFF2) + (size_t)l * D * DFF, MTOK, D, DFF, DFF, DFF, 1 << 20, 0}; pg8::StaticOrder S; S.init(MTOK, D, G, bid);
          EpiResid E{X, rep == REP_FF2 - 1 ? X : (float*)PROJ, modl + 5 * 2048}; pg8::gemm_phase<EpiResid>(lds, g, S, E); }
        }
        GRID_BAR();
#endif
    }
}

extern "C" void kernel_launch(void* const* d_in, const int* in_sizes, int n_in, void* d_out, int out_size, void* d_ws, size_t ws_size, hipStream_t stream) {
    static int grid = 0;
    if (grid == 0) {
        if (n_in != N_IN || (size_t)out_size != O_END || ws_size < WS_END) { fprintf(stderr, "kernel_launch: unexpected shapes (n_in %d, out %d, ws %zu; need ws >= %zu)\n", n_in, out_size, ws_size, (size_t)WS_END); grid = -1; return; }
        int dev = 0, cus = 0;
        if (hipGetDevice(&dev) != hipSuccess || hipDeviceGetAttribute(&cus, hipDeviceAttributeMultiprocessorCount, dev) != hipSuccess) { grid = -1; return; }
        if (hipFuncSetAttribute((const void*)fwd_kernel, hipFuncAttributeMaxDynamicSharedMemorySize, LDS_BYTES) != hipSuccess) { fprintf(stderr, "kernel_launch: hipFuncSetAttribute failed\n"); grid = -1; return; }
        int per_cu = 0;
        if (hipOccupancyMaxActiveBlocksPerMultiprocessor(&per_cu, (const void*)fwd_kernel, 512, LDS_BYTES) != hipSuccess || per_cu < 1) { fprintf(stderr, "kernel_launch: occupancy query says %d blocks per CU\n", per_cu); grid = -1; (void)hipGetLastError(); return; }
        grid = cus;
    }
    if (grid < 0) return;
    (void)hipMemsetAsync((char*)d_ws + WS_CTL, 0, CTL_ZERO_BYTES, stream);
    Args a{};
    for (int i = 0; i < N_IN; ++i) a.in[i] = (const float*)d_in[i];
    a.out = (float*)d_out; a.ws = (unsigned char*)d_ws;
    hipLaunchKernelGGL(fwd_kernel, dim3(grid), dim3(512), LDS_BYTES, stream, a);
}
```

```cpp
#include <hip/hip_runtime.h>
#include <cstdio>
#include <cstdint>

#define LAS __attribute__((address_space(3)))
typedef unsigned short bf16_t;
typedef short bf16x8 __attribute__((ext_vector_type(8)));
typedef short s16x4 __attribute__((ext_vector_type(4)));
typedef float f32x4 __attribute__((ext_vector_type(4)));
typedef float f32x2 __attribute__((ext_vector_type(2)));
typedef unsigned u32x4 __attribute__((ext_vector_type(4)));
typedef unsigned u32x2 __attribute__((ext_vector_type(2)));

namespace pg8 {
constexpr int BM = 256, BK = 64, HALF = 128, HTB = HALF * BK * 2, STAGE_BYTES = 8 * HTB, NXCD = 8, WGM = 8;
__host__ __device__ __forceinline__ int lds_byte(int r, int c) { const int st = (r >> 4) * 2 + (c >> 5), rr = r & 15, cc = c & 31, ob = rr * 64 + cc * 2; return st * 1024 + (ob ^ (((ob >> 9) & 1) << 5)); }
__host__ __device__ __forceinline__ void stage_rc(int b, int& R, int& C) { const int st = b / 1024, sb = b % 1024, swz = sb ^ (((sb >> 9) & 1) << 5); R = (st >> 1) * 16 + swz / 64; C = (st & 1) * 32 + (swz % 64) / 2; }
__host__ __device__ __forceinline__ int perm32(int rho) { const int n = rho >> 4, i = rho & 15; return 8 * (i >> 2) + 4 * n + (i & 3); }
struct Unit { int pm, pn; };
struct Gemm { const bf16_t* A; const bf16_t* Bt; int M, N, K, lda, ldb, a_shift, a_mask, a_gstride; };
struct StaticOrder {
    int nM, nN, nwg, G, c;
    __host__ __device__ void init(int M, int N, int G_, int c_) { nM = M / BM; nN = N / BM; nwg = nM * nN; G = G_; c = c_; }
    __host__ __device__ bool next(int i, Unit& u) const {
        const long L = (long)i * G + c; if (L >= nwg) return false;
        int wgid = (int)L; { const int q = nwg / NXCD, r = nwg % NXCD, xcd = wgid % NXCD, off = wgid / NXCD; wgid = (xcd < r ? xcd * (q + 1) : r * (q + 1) + (xcd - r) * q) + off; }
        const int nig = WGM * nN, gid = wgid / nig, fm = gid * WGM, gsz = (nM - fm) < WGM ? (nM - fm) : WGM;
        u.pm = fm + ((wgid % nig) % gsz); u.pn = (wgid % nig) / gsz; return true;
    }
};
__device__ __forceinline__ unsigned cvt_pk_bf16(float lo, float hi) { unsigned r; asm volatile("v_cvt_pk_bf16_f32 %0, %1, %2" : "=v"(r) : "v"(lo), "v"(hi)); return r; }

template <class Epi>
__device__ __forceinline__ void gemm_phase(LAS unsigned char* lds, const Gemm g, const StaticOrder& S, const Epi& E) {
    int tid = threadIdx.x; asm volatile("" : "+v"(tid)); const int wid = __builtin_amdgcn_readfirstlane(tid >> 6), lane = tid & 63, wr = wid >> 2, wc = wid & 3, fr = lane & 15, fq = lane >> 4;
    int K_ = g.K; asm volatile("" : "+s"(K_)); const int K = K_, nt = K / BK;
    unsigned voffA[2], voffB[2];
#pragma unroll
    for (int i = 0; i < 2; ++i) { int R, C; stage_rc(tid * 16 + i * 8192, R, C); const int Rb = Epi::PERM ? ((R & ~31) + perm32(R & 31)) : R;
        voffA[i] = (unsigned)(R * g.lda + C) * 2u; voffB[i] = (unsigned)(Rb * g.ldb + C) * 2u; }
    const size_t kstep = (size_t)(BK * 2);
    const size_t hsA = (size_t)HALF * g.lda * 2, hsB = (size_t)HALF * g.ldb * 2;
    const unsigned ldsw = (unsigned)wid * 1024u;
    const int aoff = lds_byte(wr * 64 + fr, fq * 8), boff = lds_byte(wc * 32 + fr, fq * 8);
#define PG8_SA(b, h) (((b) * 2 + (h)) * HTB)
#define PG8_SB(b, h) ((4 + (b) * 2 + (h)) * HTB)
#define PG8_STAGE(bufoff, gbase, voff) do { _Pragma("unroll") for (int _i = 0; _i < 2; ++_i) \
        __builtin_amdgcn_global_load_lds((const unsigned*)((const char*)(gbase) + (voff)[_i]), (LAS unsigned*)(lds + (bufoff) + ldsw + _i * 8192), 16, 0, 0); } while (0)
#define PG8_LDA(dst, b, h) do { _Pragma("unroll") for (int m = 0; m < 4; ++m) _Pragma("unroll") for (int k = 0; k < 2; ++k) dst[m][k] = *(const LAS bf16x8*)(lds + PG8_SA(b, h) + aoff + m * 2048 + k * 1024); } while (0)
#define PG8_LDB(dst, b, h) do { _Pragma("unroll") for (int n = 0; n < 2; ++n) _Pragma("unroll") for (int k = 0; k < 2; ++k) dst[n][k] = *(const LAS bf16x8*)(lds + PG8_SB(b, h) + boff + n * 2048 + k * 1024); } while (0)
#define PG8_MMA(ai, bj, At, Bt) do { __builtin_amdgcn_s_setprio(1); _Pragma("unroll") for (int m = 0; m < 4; ++m) _Pragma("unroll") for (int n = 0; n < 2; ++n) _Pragma("unroll") for (int k = 0; k < 2; ++k) \
        acc[ai][bj][m][n] = __builtin_amdgcn_mfma_f32_16x16x32_bf16(Bt[n][k], At[m][k], acc[ai][bj][m][n], 0, 0, 0); __builtin_amdgcn_s_setprio(0); } while (0)
#define PG8_WAIT_V(n) asm volatile("s_waitcnt vmcnt(" #n ")" ::: "memory")
#define PG8_WAIT_L(n) asm volatile("s_waitcnt lgkmcnt(" #n ")" ::: "memory")
#define PG8_BAR __builtin_amdgcn_s_barrier()
#define PG8_SCHED __builtin_amdgcn_sched_barrier(0)
#define PG8_UA(u) ((const char*)g.A + (size_t)(u).pm * 2 * hsA + (size_t)((((u).pn >> g.a_shift) & g.a_mask) * g.a_gstride) * 2)
#define PG8_UB(u) ((const char*)g.Bt + (size_t)(u).pn * 2 * hsB)
    Unit cur, nxt; int ui = 0;
    if (!S.next(0, cur)) return;
    f32x4 acc[2][2][4][2];
#pragma unroll
    for (int a = 0; a < 2; ++a)
#pragma unroll
        for (int b = 0; b < 2; ++b)
#pragma unroll
            for (int m = 0; m < 4; ++m)
#pragma unroll
                for (int n = 0; n < 2; ++n) acc[a][b][m][n] = (f32x4){0.f, 0.f, 0.f, 0.f};
    bf16x8 At[4][2], B0[2][2], B1[2][2];
    const char* cA = PG8_UA(cur); const char* cB = PG8_UB(cur);
    PG8_STAGE(PG8_SB(0, 0), cB, voffB); PG8_STAGE(PG8_SB(0, 1), cB + hsB, voffB); PG8_STAGE(PG8_SA(0, 0), cA, voffA); PG8_STAGE(PG8_SA(0, 1), cA + hsA, voffA);
    if (wr == 1) PG8_BAR;
    PG8_WAIT_V(2); PG8_BAR;
    PG8_STAGE(PG8_SB(1, 0), cB + kstep, voffB); PG8_STAGE(PG8_SA(1, 0), cA + kstep, voffA); PG8_STAGE(PG8_SB(1, 1), cB + hsB + kstep, voffB);
    PG8_WAIT_V(6); PG8_BAR;
    for (;;) {
        const bool has_next = S.next(ui + 1, nxt);
        const char* nA = has_next ? PG8_UA(nxt) : cA; const char* nB = has_next ? PG8_UB(nxt) : cB;
        for (int t = 0; t < nt; t += 2) {
            const bool last = (t == nt - 2);
            const char* a1 = cA + (size_t)(t + 1) * kstep;
            const char* a2 = last ? nA : cA + (size_t)(t + 2) * kstep; const char* b2 = last ? nB : cB + (size_t)(t + 2) * kstep;
            const char* a3 = a2 + kstep; const char* b3 = b2 + kstep;
            PG8_LDB(B0, 0, 0); PG8_LDB(B1, 0, 1); PG8_SCHED; PG8_LDA(At, 0, 0); PG8_STAGE(PG8_SA(1, 1), a1 + hsA, voffA);
            PG8_WAIT_V(8); PG8_WAIT_L(0); PG8_BAR; PG8_MMA(0, 0, At, B0); PG8_MMA(0, 1, At, B1); PG8_BAR; PG8_SCHED;
            PG8_LDA(At, 0, 1); PG8_STAGE(PG8_SB(0, 0), b2, voffB); PG8_STAGE(PG8_SB(0, 1), b2 + hsB, voffB); PG8_STAGE(PG8_SA(0, 0), a2, voffA);
            PG8_WAIT_V(8); PG8_WAIT_L(0); PG8_BAR; PG8_MMA(1, 0, At, B0); PG8_MMA(1, 1, At, B1); PG8_BAR; PG8_SCHED;
            PG8_LDB(B0, 1, 0); PG8_LDB(B1, 1, 1); PG8_SCHED; PG8_LDA(At, 1, 0); PG8_STAGE(PG8_SA(0, 1), a2 + hsA, voffA);
            PG8_WAIT_V(8); PG8_WAIT_L(0); PG8_BAR; PG8_MMA(0, 0, At, B0); PG8_MMA(0, 1, At, B1); PG8_BAR; PG8_SCHED;
            PG8_LDA(At, 1, 1); PG8_STAGE(PG8_SB(1, 0), b3, voffB); PG8_STAGE(PG8_SB(1, 1), b3 + hsB, voffB); PG8_STAGE(PG8_SA(1, 0), a3, voffA);
            PG8_WAIT_V(8); PG8_WAIT_L(0); PG8_BAR; PG8_MMA(1, 0, At, B0); PG8_MMA(1, 1, At, B1); PG8_BAR; PG8_SCHED;
        }
        if (wr == 0) PG8_BAR;
        E(acc, cur, wr, wc, fr, fq);
        if (!has_next) break;
#pragma unroll
        for (int a = 0; a < 2; ++a)
#pragma unroll
            for (int b = 0; b < 2; ++b)
#pragma unroll
                for (int m = 0; m < 4; ++m)
#pragma unroll
                    for (int n = 0; n < 2; ++n) acc[a][b][m][n] = (f32x4){0.f, 0.f, 0.f, 0.f};
        cur = nxt; cA = nA; cB = nB; ++ui;
        if (wr == 1) PG8_BAR;
    }
    PG8_WAIT_V(0);
    PG8_BAR;
#undef PG8_SA
#undef PG8_SB
#undef PG8_STAGE
#undef PG8_LDA
#undef PG8_LDB
#undef PG8_MMA
#undef PG8_WAIT_V
#undef PG8_WAIT_L
#undef PG8_BAR
#undef PG8_SCHED
#undef PG8_UA
#undef PG8_UB
}
}
#define XB_TMO      128
#define XB_XCNT(j)  (256  + 64 * (j))
#define XB_XSUB(j)  (1280 + 64 * (j))
#define XB_XGEN(j)  (2304 + 64 * (j))
#define XB_TOP      3328
#define XB_TOPGEN   3392
#define XCD_BAR_WORDS 3456
#define XB_SPIN_CAP (1u << 18)

__device__ __forceinline__ unsigned xb_ld(unsigned* p)              { return __hip_atomic_load(p, __ATOMIC_RELAXED, __HIP_MEMORY_SCOPE_AGENT); }
__device__ __forceinline__ unsigned xb_add(unsigned* p, unsigned v) { return __hip_atomic_fetch_add(p, v, __ATOMIC_RELAXED, __HIP_MEMORY_SCOPE_AGENT); }
__device__ __forceinline__ unsigned xb_xcc_id() { return (unsigned)__builtin_amdgcn_s_getreg((3 << 11) | 20) & 0xFu; }
#define XB_SPIN(cond, bar) do { unsigned _sp = 0; while (cond) { __builtin_amdgcn_s_sleep(1); \
    if ((++_sp & 255u) == 0u) { if (xb_ld(&(bar)[XB_TMO])) break; if (_sp > XB_SPIN_CAP) { atomicAdd(&(bar)[XB_TMO], 1u); break; } } } } while (0)

struct XcdBarrier {
    unsigned* bar; unsigned x;
    volatile LAS unsigned* st;
};

__device__ __forceinline__ XcdBarrier xcd_barrier_post(unsigned* bar, volatile LAS unsigned* st) {
    XcdBarrier b; b.bar = bar; b.x = xb_xcc_id(); b.st = st;
    if (threadIdx.x == 0) (void)xb_add(&bar[XB_XCNT(b.x)], 1u);
    return b;
}
__device__ __forceinline__ void xcd_barrier_complete(unsigned* bar, unsigned x, unsigned& nloc, unsigned& nx) {
    const unsigned G = gridDim.x * gridDim.y * gridDim.z;
    unsigned sum, cnt, mine, sp = 0u;
    for (;;) {
        sum = 0u; cnt = 0u; mine = 0u;
#pragma unroll
        for (unsigned j = 0; j < 16; ++j) { const unsigned c = xb_ld(&bar[XB_XCNT(j)]); sum += c; cnt += (c > 0u) ? 1u : 0u; mine = (j == x) ? c : mine; }
        if (sum == G) break;
        __builtin_amdgcn_s_sleep(1);
        if ((++sp & 255u) == 0u) { if (xb_ld(&bar[XB_TMO])) break; if (sp > XB_SPIN_CAP) { atomicAdd(&bar[XB_TMO], 1u); break; } }
    }
    nloc = mine > 0u ? mine : 1u; nx = cnt > 0u ? cnt : 1u;
}

__device__ __forceinline__ void xcd_barrier(const XcdBarrier& b) {
    asm volatile("s_waitcnt vmcnt(0)" ::: "memory");
    __syncthreads();
    if (threadIdx.x == 0) {
        unsigned* bar = b.bar;
        __builtin_amdgcn_s_waitcnt(0);
        unsigned nloc = b.st[0], nx = b.st[1];
        if (nloc == 0u) { xcd_barrier_complete(bar, b.x, nloc, nx); b.st[0] = nloc; b.st[1] = nx; }
        const unsigned old = xb_add(&bar[XB_XSUB(b.x)], 1u);
        const unsigned gen = old / nloc;
        if (old + 1u == (gen + 1u) * nloc) {
            __builtin_amdgcn_fence(__ATOMIC_RELEASE, "agent");
            asm volatile("s_waitcnt vmcnt(0)" ::: "memory");
            const unsigned og = xb_add(&bar[XB_TOP], 1u);
            const unsigned tg = og / nx;
            if (og + 1u == (tg + 1u) * nx) xb_add(&bar[XB_TOPGEN], 1u);
            else XB_SPIN(xb_ld(&bar[XB_TOPGEN]) == tg, bar);
            __builtin_amdgcn_fence(__ATOMIC_ACQUIRE, "agent");
            xb_add(&bar[XB_XGEN(b.x)], 1u);
            asm volatile("s_waitcnt vmcnt(0)" ::: "memory");
        } else {
            XB_SPIN(xb_ld(&bar[XB_XGEN(b.x)]) == gen, bar);
            __builtin_amdgcn_fence(__ATOMIC_ACQUIRE, "agent");
            asm volatile("s_waitcnt vmcnt(0)" ::: "memory");
        }
    }
    __syncthreads();
}

constexpr int D = 2048, MCTX = 8192, MLAT = 16384, MTOK = 24576, DEPTH = 4, DFF = 8192;
constexpr int NPROJ = 4608;
constexpr int C_RQ = 0, C_RK = 512, C_RV = 1024, C_RG = 1536, C_LX = 2048, C_LG = 2560, C_AQ = 3072, C_AK = 3584, C_AV = 3840, C_SU = 4096;
constexpr int NCHUNK16 = MTOK / 16;
constexpr int NCHUNK128 = MTOK / 128;
constexpr float EPS = 1e-6f, LOG2E = 1.4426950408889634f;
enum { I_XP = 0, I_XS, I_CK, I_CV, I_SRET, I_SLRU, I_SSRE, I_SSIM, I_C, I_CCTX, I_WMOD, I_BMOD, I_NORM1, I_WIN, I_RDEC, I_RGN, I_LCW, I_LCB, I_LWA, I_LBA, I_LWX, I_LBX, I_LLAM,
       I_QN, I_KN, I_SINK, I_SARE, I_SAIM, I_SLDT, I_SBRE, I_SBIM, I_SCRE, I_SCIM, I_SD, I_SWGLU, I_SBGLU, I_WBR, I_WOUT, I_NORM2, I_WFF1, I_WFF2, N_IN };
constexpr size_t O_YP = 0, O_YS = 16777216, O_NK = 50331648, O_NV = 58720256, O_NRET = 67108864, O_NLRU = 83886080, O_NSRE = 84017152, O_NSIM = 84541440, O_END = 85065728;
constexpr size_t MiB = 1u << 20;
constexpr size_t WS_CTL = 0, CTL_ZERO_BYTES = 1 * MiB;
constexpr size_t WS_MOD = 1 * MiB;
constexpr size_t WS_A16 = 3 * MiB;
constexpr size_t WS_SPV = WS_A16 + 512 * 1024;
constexpr size_t WS_SSMK = 4 * MiB;
constexpr size_t WS_SSMC = 20 * MiB;
constexpr size_t WS_SSMB = 36 * MiB;
constexpr size_t WS_WGLU = 52 * MiB;
constexpr size_t WS_WLRU = 54 * MiB;
constexpr size_t WS_WIN1 = 62 * MiB;
constexpr size_t WS_WGATE = 134 * MiB;
constexpr size_t WS_WBR = 262 * MiB;
constexpr size_t WS_WOUT = 294 * MiB;
constexpr size_t WS_WFF1 = 326 * MiB;
constexpr size_t WS_WFF2 = 454 * MiB;
constexpr size_t WS_H = 582 * MiB;
constexpr size_t WS_PROJ = 678 * MiB;
constexpr size_t WS_O = 894 * MiB;
constexpr size_t WS_P = 990 * MiB;
constexpr size_t WS_MG = 1374 * MiB;
constexpr size_t WS_XB = 1470 * MiB;
constexpr size_t WS_END = 1566 * MiB;
constexpr size_t WS_XC = WS_P;
constexpr size_t WS_LA = WS_XC + 24 * MiB;
constexpr size_t WS_LB = WS_LA + 48 * MiB;
constexpr size_t WS_HF = WS_LB + 48 * MiB;
constexpr size_t WS_YS = WS_HF + 48 * MiB;
constexpr size_t WS_BU = WS_YS + 24 * MiB;
constexpr size_t WS_HS = WS_BU + 48 * MiB;
constexpr size_t WS_KV = WS_HS + 24 * MiB;
constexpr size_t WS_SIN = WS_KV + 96 * MiB;
static_assert(WS_SIN + 48 * MiB <= WS_XB, "mixer temporaries fit");
constexpr int CW_BAR = 4096;
constexpr int LDS_BYTES = 147456, LDS_MISC = 143360;

typedef const float* fptr_t;
typedef __attribute__((address_space(4))) const fptr_t* tab_t;
__device__ __forceinline__ tab_t in_tab() { tab_t t = (tab_t)__builtin_amdgcn_kernarg_segment_ptr(); asm volatile("" : "+s"(t)); return t; }
#define INP(i) (in_tab()[i])
__device__ __forceinline__ float bf2f(unsigned short b) { return __uint_as_float(((unsigned)b) << 16); }
__device__ __forceinline__ float bflo(unsigned w) { return __uint_as_float(w << 16); }
__device__ __forceinline__ float bfhi(unsigned w) { return __uint_as_float(w & 0xffff0000u); }
__device__ __forceinline__ unsigned pk2(float lo, float hi) { return pg8::cvt_pk_bf16(lo, hi); }
__device__ __forceinline__ bf16x8 pack8(const f32x4 a, const f32x4 b) { u32x4 w; w.x = pk2(a[0], a[1]); w.y = pk2(a[2], a[3]); w.z = pk2(b[0], b[1]); w.w = pk2(b[2], b[3]); return __builtin_bit_cast(bf16x8, w); }
__device__ __forceinline__ float sigmoidf_(float x) { return __builtin_amdgcn_rcpf(1.0f + __builtin_amdgcn_exp2f(-x * LOG2E)); }
__device__ __forceinline__ float siluf_(float x) { return x * sigmoidf_(x); }
__device__ __forceinline__ float gelu_tanh(float x) {
    const float u = 0.7978845608028654f * (x + 0.044715f * x * x * x); return x * sigmoidf_(2.0f * u); }
__device__ __forceinline__ f32x4 mfma16(bf16x8 a, bf16x8 b, f32x4 c) { return __builtin_amdgcn_mfma_f32_16x16x32_bf16(a, b, c, 0, 0, 0); }
__device__ __forceinline__ bf16x8 frag_tr(const LAS unsigned char* img, int ldb, int klo, int khi, int n0, int lane) {
    const int q = (lane & 15) >> 2, p = lane & 3;
    const s16x4 lo = __builtin_amdgcn_ds_read_tr16_b64_v4i16((LAS s16x4*)(img + (klo + q) * ldb + (n0 + 4 * p) * 2));
    const s16x4 hi = __builtin_amdgcn_ds_read_tr16_b64_v4i16((LAS s16x4*)(img + (khi + q) * ldb + (n0 + 4 * p) * 2));
    return __builtin_shufflevector(lo, hi, 0, 1, 2, 3, 4, 5, 6, 7);
}
template <int R> __device__ __forceinline__ void stage_rows(LAS unsigned char* img, int ldl, const bf16_t* src, size_t ldg, int tid) {
#pragma unroll
    for (int c = tid; c < R * 16; c += 512) { const int row = c >> 4, ch = c & 15; *(LAS u32x4*)(img + row * ldl + ch * 16) = *(const u32x4*)(src + (size_t)row * ldg + ch * 8); }
}
__device__ __forceinline__ int mod_row(int pm) { return pm < 32 ? 0 : 1 + ((pm - 32) >> 3); }

struct EpiStore {
    static constexpr bool PERM = true;
    bf16_t* O; int ldc; int relu2; int dry;
    __device__ __forceinline__ void operator()(const f32x4 (&acc)[2][2][4][2], const pg8::Unit& u, int wr, int wc, int fr, int fq) const {
        const int row0 = u.pm * 256 + wr * 64 + fr, col0 = u.pn * 256 + wc * 32 + 8 * fq;
#pragma unroll
        for (int ai = 0; ai < 2; ++ai)
#pragma unroll
            for (int m = 0; m < 4; ++m) { bf16_t* rowp = O + (size_t)(row0 + ai * 128 + m * 16) * ldc + col0;
#pragma unroll
                for (int bj = 0; bj < 2; ++bj) { f32x4 v0 = acc[ai][bj][m][0], v1 = acc[ai][bj][m][1];
                    if (relu2) {
#pragma unroll
                        for (int j = 0; j < 4; ++j) { const float a = fmaxf(v0[j], 0.f), b = fmaxf(v1[j], 0.f); v0[j] = a * a; v1[j] = b * b; } }
                    u32x4 w; w.x = pk2(v0[0], v0[1]); w.y = pk2(v0[2], v0[3]); w.z = pk2(v1[0], v1[1]); w.w = pk2(v1[2], v1[3]);
                    if (dry) asm volatile("" :: "v"(w)); else *(u32x4*)(rowp + bj * 128) = w; } }
    }
};
struct EpiResid {
    static constexpr bool PERM = true;
    const bf16_t* Xi; bf16_t* Xo; float* Xf; const float* gmod; int dry;
    __device__ __forceinline__ void operator()(const f32x4 (&acc)[2][2][4][2], const pg8::Unit& u, int wr, int wc, int fr, int fq) const {
        const int row0 = u.pm * 256 + wr * 64 + fr, col0 = u.pn * 256 + wc * 32 + 8 * fq;
        const float* gp = gmod + (size_t)mod_row(u.pm) * 12288 + col0;
        f32x4 gv[2][2];
#pragma unroll
        for (int bj = 0; bj < 2; ++bj)
#pragma unroll
            for (int n = 0; n < 2; ++n) gv[bj][n] = *(const f32x4*)(gp + bj * 128 + n * 4);
#pragma unroll
        for (int ai = 0; ai < 2; ++ai)
#pragma unroll
            for (int m = 0; m < 4; ++m) { const size_t ro = (size_t)(row0 + ai * 128 + m * 16) * D + col0;
#pragma unroll
                for (int bj = 0; bj < 2; ++bj) { const size_t o = ro + bj * 128;
                    if (dry) { const f32x4 t_ = gv[bj][0] * acc[ai][bj][m][0] + gv[bj][1] * acc[ai][bj][m][1]; asm volatile("" :: "v"(t_)); continue; }
                    const u32x4 xw = *(const u32x4*)(Xi + o);
                    f32x4 v0 = (f32x4){bflo(xw.x), bfhi(xw.x), bflo(xw.y), bfhi(xw.y)} + gv[bj][0] * acc[ai][bj][m][0];
                    f32x4 v1 = (f32x4){bflo(xw.z), bfhi(xw.z), bflo(xw.w), bfhi(xw.w)} + gv[bj][1] * acc[ai][bj][m][1];
                    if (Xf) { *(f32x4*)(Xf + o) = v0; *(f32x4*)(Xf + o + 4) = v1; }
                    else { u32x4 w; w.x = pk2(v0[0], v0[1]); w.y = pk2(v0[2], v0[3]); w.z = pk2(v1[0], v1[1]); w.w = pk2(v1[2], v1[3]); *(u32x4*)(Xo + o) = w; } } }
    }
};
struct EpiGate {
    static constexpr bool PERM = false;
    const bf16_t* P; bf16_t* MG;
    __device__ __forceinline__ void operator()(const f32x4 (&acc)[2][2][4][2], const pg8::Unit& u, int wr, int wc, int fr, int fq) const {
        const int row0 = u.pm * 256 + wr * 64 + fr, ch0 = u.pn * 64 + wc * 16 + 4 * fq;
#pragma unroll
        for (int ai = 0; ai < 2; ++ai)
#pragma unroll
            for (int m = 0; m < 4; ++m) { const size_t row = (size_t)(row0 + ai * 128 + m * 16);
                f32x4 s = (f32x4){0.f, 0.f, 0.f, 0.f};
#pragma unroll
                for (int b = 0; b < 4; ++b) { const u32x2 pw = *(const u32x2*)(P + row * 8192 + b * 2048 + ch0); const f32x4 a = acc[ai][b >> 1][m][b & 1];
                    s[0] += sigmoidf_(a[0]) * bflo(pw.x); s[1] += sigmoidf_(a[1]) * bfhi(pw.x); s[2] += sigmoidf_(a[2]) * bflo(pw.y); s[3] += sigmoidf_(a[3]) * bfhi(pw.y); }
                u32x2 w; w.x = pk2(s[0], s[1]); w.y = pk2(s[2], s[3]); *(u32x2*)(MG + row * D + ch0) = w; }
    }
};
struct EpiLru {
    static constexpr bool PERM = true;
    const bf16_t* XC; bf16_t* LA; bf16_t* LB; const float* ba; const float* bx; const float* lam;
    __device__ __forceinline__ void operator()(const f32x4 (&acc)[2][2][4][2], const pg8::Unit& u, int wr, int wc, int fr, int fq) const {
        const int row0 = u.pm * 256 + wr * 64 + fr, d = u.pn >> 2;
#pragma unroll
        for (int n = 0; n < 2; ++n) { const int ch0 = (u.pn & 3) * 128 + wc * 32 + 8 * fq + 4 * n;
            const f32x4 bav = *(const f32x4*)(ba + d * 512 + ch0), bxv = *(const f32x4*)(bx + d * 512 + ch0), spv = *(const f32x4*)(lam + d * 512 + ch0);
#pragma unroll
            for (int ai = 0; ai < 2; ++ai)
#pragma unroll
                for (int m = 0; m < 4; ++m) { const size_t row = (size_t)(row0 + ai * 128 + m * 16);
                    const u32x2 xw = *(const u32x2*)(XC + row * 512 + ch0);
                    const f32x4 xv = (f32x4){bflo(xw.x), bfhi(xw.x), bflo(xw.y), bfhi(xw.y)};
                    f32x4 la, lb;
#pragma unroll
                    for (int e = 0; e < 4; ++e) { const float r = sigmoidf_(acc[ai][0][m][n][e] + bav[e]), ig = sigmoidf_(acc[ai][1][m][n][e] + bxv[e]);
                        const float l2 = r * spv[e], a = __builtin_amdgcn_exp2f(l2); la[e] = l2; lb[e] = sqrtf(fmaxf(1.0f - a * a, 0.f)) * ig * xv[e]; }
                    u32x2 w; w.x = pk2(la[0], la[1]); w.y = pk2(la[2], la[3]); *(u32x2*)(LA + row * 1024 + d * 512 + ch0) = w;
                    w.x = pk2(lb[0], lb[1]); w.y = pk2(lb[2], lb[3]); *(u32x2*)(LB + row * 1024 + d * 512 + ch0) = w; } }
    }
};
struct EpiGlu {
    static constexpr bool PERM = true;
    const bf16_t* YS; bf16_t* O; const float* bg;
    __device__ __forceinline__ void operator()(const f32x4 (&acc)[2][2][4][2], const pg8::Unit& u, int wr, int wc, int fr, int fq) const {
        const int row0 = u.pm * 256 + wr * 64 + fr, col0 = u.pn * 256 + wc * 32 + 8 * fq;
#pragma unroll
        for (int ai = 0; ai < 2; ++ai)
#pragma unroll
            for (int m = 0; m < 4; ++m) { const size_t row = (size_t)(row0 + ai * 128 + m * 16);
#pragma unroll
                for (int bj = 0; bj < 2; ++bj) { const int col = col0 + bj * 128;
                    const u32x4 yw = *(const u32x4*)(YS + row * 512 + col);
                    const float yv[8] = {bflo(yw.x), bfhi(yw.x), bflo(yw.y), bfhi(yw.y), bflo(yw.z), bfhi(yw.z), bflo(yw.w), bfhi(yw.w)};
                    float o[8];
#pragma unroll
                    for (int e = 0; e < 8; ++e) o[e] = yv[e] * sigmoidf_(acc[ai][bj][m][e >> 2][e & 3] + bg[col + e]);
                    u32x4 w; w.x = pk2(o[0], o[1]); w.y = pk2(o[2], o[3]); w.z = pk2(o[4], o[5]); w.w = pk2(o[6], o[7]);
                    *(u32x4*)(O + row * D + 1536 + col) = w; } }
    }
};

template <int MODE> __device__ __forceinline__ int src_col(int n_out, int coloff) {
    if (MODE == 0) return coloff + n_out;
    const int pn = n_out >> 8, c = n_out & 255, b = 2 * (c >> 7) + ((c >> 4) & 1), chl = 16 * ((c >> 5) & 3) + (c & 15);
    return coloff + b * 2048 + pn * 64 + chl;
}
template <int MODE> __device__ __forceinline__ void tr_item(const float* W, int ldsrc, int coloff, int K, bf16_t* WT, int row_off, int nblk, LAS float* scr, int item, int lane) {
    const int kb = item / nblk, nb = item % nblk, k0 = 64 * kb, n0 = 32 * nb;
    const int col = src_col<MODE>(n0 + (lane & 31), coloff);
#pragma unroll
    for (int i = 0; i < 32; ++i) { const int kk = 2 * i + (lane >> 5); scr[kk * 33 + (lane & 31)] = W[(size_t)(k0 + kk) * ldsrc + col]; }
    asm volatile("s_waitcnt lgkmcnt(0)" ::: "memory");
    const int c = lane & 7;
#pragma unroll
    for (int j = 0; j < 4; ++j) { const int n = (lane >> 3) + 8 * j; const LAS float* s = scr + (8 * c) * 33 + n;
        u32x4 o; o.x = pk2(s[0 * 33], s[1 * 33]); o.y = pk2(s[2 * 33], s[3 * 33]); o.z = pk2(s[4 * 33], s[5 * 33]); o.w = pk2(s[6 * 33], s[7 * 33]);
        *(u32x4*)(WT + (size_t)(row_off + n0 + n) * K + k0 + 8 * c) = o; }
    asm volatile("s_waitcnt lgkmcnt(0)" ::: "memory");
}
__device__ __forceinline__ void prologue_weights(tab_t in, unsigned char* ws, LAS unsigned char* lds, int gw, int NGW, int wave, int lane) {
    LAS float* scr = (LAS float*)(lds + wave * 16384);
    constexpr int I1 = 32 * 144, I2 = 32 * 256, I3 = 8 * 64, I4 = 32 * 64, I5 = 32 * 256, I6 = 128 * 64, I7 = 8 * 16;
    constexpr int PER = I1 + I2 + 4 * I3 + I4 + I5 + I6 + I7;
    for (int it = gw; it < DEPTH * PER; it += NGW) {
        const int l = it / PER; int r = it % PER;
        if (r < I1) { tr_item<0>(in[I_WIN] + (size_t)l * 2048 * 12800, 12800, 0, 2048, (bf16_t*)(ws + WS_WIN1) + (size_t)l * 4608 * 2048, 0, 144, scr, r, lane); continue; } r -= I1;
        if (r < I2) { tr_item<1>(in[I_WIN] + (size_t)l * 2048 * 12800, 12800, 4608, 2048, (bf16_t*)(ws + WS_WGATE) + (size_t)l * 8192 * 2048, 0, 256, scr, r, lane); continue; } r -= I2;
        if (r < 4 * I3) { const int b = r / I3; tr_item<0>(in[I_WBR] + (size_t)(l * 4 + b) * 512 * 2048, 2048, 0, 512, (bf16_t*)(ws + WS_WBR) + (size_t)l * 8192 * 512, b * 2048, 64, scr, r % I3, lane); continue; } r -= 4 * I3;
        if (r < I4) { tr_item<0>(in[I_WOUT] + (size_t)l * 2048 * 2048, 2048, 0, 2048, (bf16_t*)(ws + WS_WOUT) + (size_t)l * 2048 * 2048, 0, 64, scr, r, lane); continue; } r -= I4;
        if (r < I5) { tr_item<0>(in[I_WFF1] + (size_t)l * 2048 * 8192, 8192, 0, 2048, (bf16_t*)(ws + WS_WFF1) + (size_t)l * 8192 * 2048, 0, 256, scr, r, lane); continue; } r -= I5;
        if (r < I6) { tr_item<0>(in[I_WFF2] + (size_t)l * 8192 * 2048, 2048, 0, 8192, (bf16_t*)(ws + WS_WFF2) + (size_t)l * 2048 * 8192, 0, 64, scr, r, lane); continue; } r -= I6;
        tr_item<0>(in[I_SWGLU] + (size_t)l * 512 * 512, 512, 0, 512, (bf16_t*)(ws + WS_WGLU) + (size_t)l * 512 * 512, 0, 16, scr, r, lane);
    }
}
__device__ __forceinline__ void prologue_lru_w(tab_t in, unsigned char* ws, int gtid, int NT) {
    bf16_t* WL = (bf16_t*)(ws + WS_WLRU);
    for (int idx = gtid; idx < DEPTH * 2048 * 16; idx += NT) {
        const int kc = idx & 15, rr = (idx >> 4) & 2047, l = idx >> 15;
        const int pn = rr >> 8, d = pn >> 2, nb = pn & 3, c = rr & 255, gate = c >> 7, cc = c & 127;
        const float* src = (gate ? in[I_LWX] : in[I_LWA]) + ((size_t)((l * 2 + d) * 4 + nb) * 128 + kc * 8) * 128 + cc;
        u32x4 o; o.x = pk2(src[0], src[128]); o.y = pk2(src[256], src[384]); o.z = pk2(src[512], src[640]); o.w = pk2(src[768], src[896]);
        *(u32x4*)(WL + ((size_t)l * 2048 + rr) * 128 + kc * 8) = o;
    }
    for (int idx = gtid; idx < DEPTH * 1024; idx += NT) ((float*)(ws + WS_SPV))[idx] = -8.0f * LOG2E * log1pf(__expf(-in[I_LLAM][idx]));
}
__device__ __forceinline__ void prologue_mod(tab_t in, unsigned char* ws, LAS unsigned char* lds, int bid, int G, int tid, int wave, int lane) {
    LAS float* sc = (LAS float*)lds;
    LAS float* red = (LAS float*)(lds + 73728);
    for (int i = tid; i < 9 * 2048; i += 512) { const int r = i >> 11, k = i & 2047; const float v = r == 0 ? in[I_CCTX][k] : in[I_C][(r - 1) * 2048 + k]; sc[i] = siluf_(v); }
    __syncthreads();
    float* MOD = (float*)(ws + WS_MOD);
    for (int it = bid; it < DEPTH * 192; it += G) {
        const int l = it / 192, cb = it % 192, col = cb * 64 + lane, kbase = wave * 256;
        const float* w = in[I_WMOD] + ((size_t)l * 2048 + kbase) * 12288 + col;
        float acc[9];
#pragma unroll
        for (int r = 0; r < 9; ++r) acc[r] = 0.f;
#pragma unroll 4
        for (int k = 0; k < 256; k += 4) {
            const float w0 = w[(size_t)k * 12288], w1 = w[(size_t)(k + 1) * 12288], w2 = w[(size_t)(k + 2) * 12288], w3 = w[(size_t)(k + 3) * 12288];
#pragma unroll
            for (int r = 0; r < 9; ++r) { const f32x4 s4 = *(const LAS f32x4*)(sc + r * 2048 + kbase + k); acc[r] += s4[0] * w0 + s4[1] * w1 + s4[2] * w2 + s4[3] * w3; }
        }
#pragma unroll
        for (int r = 0; r < 9; ++r) red[(wave * 9 + r) * 64 + lane] = acc[r];
        __syncthreads();
        for (int i = tid; i < 576; i += 512) { const int r = i >> 6, cl = i & 63; float s = in[I_BMOD][l * 12288 + cb * 64 + cl];
#pragma unroll
            for (int w8 = 0; w8 < 8; ++w8) s += red[(w8 * 9 + r) * 64 + cl];
            MOD[(size_t)(l * 9 + r) * 12288 + cb * 64 + cl] = s; }
        __syncthreads();
    }
}
__device__ __forceinline__ void cpow(float are, float aim, float dt, float tau, float& re, float& im) {
    const float mag = __expf(are * dt * tau); float rev = aim * dt * tau * 0.15915494309189535f; rev -= rintf(rev);
    re = mag * __builtin_amdgcn_cosf(rev); im = mag * __builtin_amdgcn_sinf(rev);
}
__device__ __forceinline__ void prologue_ssm(tab_t in, unsigned char* ws, LAS unsigned char* lds, int bid, int G, int tid) {
    LAS float* pw = (LAS float*)lds;
    LAS float* bb = pw + 2 * 17 * 64 * 2;
    LAS float* cc = bb + 2 * 64 * 16 * 2;
    LAS float* kf = cc + 2 * 16 * 64 * 2;
    LAS float* cf = kf + 2 * 16 * 256;
    for (int un = bid; un < DEPTH * 32; un += G) {
        const int l = un >> 5, g = un & 31;
        __syncthreads();
        if (tid < 128) { const int d = tid >> 6, p = tid & 63; const int ix = ((l * 2 + d) * 32 + g) * 64 + p;
            const float are = in[I_SARE][ix], aim = in[I_SAIM][ix], dt = __expf(in[I_SLDT][(l * 2 + d) * 32 + g]);
            for (int tau = 0; tau <= 16; ++tau) { float re, im; cpow(are, aim, dt, (float)tau, re, im); pw[((d * 17 + tau) * 64 + p) * 2] = re; pw[((d * 17 + tau) * 64 + p) * 2 + 1] = im;
                if (tau == 16) { float* A16 = (float*)(ws + WS_A16); A16[ix * 2] = re; A16[ix * 2 + 1] = im; }
                if (tau == 1) { const float zr = re - 1.0f, zi = im, den = 1.0f / (are * are + aim * aim); cf[(d * 64 + p) * 2] = (zr * are + zi * aim) * den; cf[(d * 64 + p) * 2 + 1] = (zi * are - zr * aim) * den; } }
        }
        __syncthreads();
        for (int i = tid; i < 2048; i += 512) { const int d = i >> 10, p = (i >> 4) & 63, c = i & 15;
            const size_t bix = ((size_t)((l * 2 + d) * 32 + g) * 64 + p) * 16 + c; const float br = in[I_SBRE][bix], bi = in[I_SBIM][bix], fr = cf[(d * 64 + p) * 2], fi = cf[(d * 64 + p) * 2 + 1];
            bb[i * 2] = fr * br - fi * bi; bb[i * 2 + 1] = fr * bi + fi * br;
            const int c2 = (i >> 6) & 15, p2 = i & 63; const size_t cix = ((size_t)((l * 2 + d) * 32 + g) * 16 + c2) * 64 + p2;
            cc[i * 2] = in[I_SCRE][cix]; cc[i * 2 + 1] = in[I_SCIM][cix]; }
        __syncthreads();
        for (int i = tid; i < 8192; i += 512) { const int d = i >> 12, tau = (i >> 8) & 15, c = (i >> 4) & 15, c2 = i & 15; float s = 0.f;
            for (int p = 0; p < 64; ++p) { const float cr = cc[((d * 16 + c) * 64 + p) * 2], ci = cc[((d * 16 + c) * 64 + p) * 2 + 1], ar = pw[((d * 17 + tau) * 64 + p) * 2], ai = pw[((d * 17 + tau) * 64 + p) * 2 + 1];
                const float wr = cr * ar - ci * ai, wi = cr * ai + ci * ar; s += wr * bb[((d * 64 + p) * 16 + c2) * 2] - wi * bb[((d * 64 + p) * 16 + c2) * 2 + 1]; }
            kf[i] = s; }
        __syncthreads();
        bf16_t* KM = (bf16_t*)(ws + WS_SSMK) + (size_t)(l * 32 + g) * 65536;
        bf16_t* CM = (bf16_t*)(ws + WS_SSMC) + (size_t)(l * 32 + g) * 65536;
        bf16_t* BMp = (bf16_t*)(ws + WS_SSMB) + (size_t)(l * 32 + g) * 65536;
        for (int i = tid; i < 32768; i += 512) {
            const int row = i >> 7, col = (i & 127) * 2;
            float v[2], w[2], z[2];
#pragma unroll
            for (int e = 0; e < 2; ++e) { const int cl = col + e;
                { const int t = row >> 4, c = row & 15, s = cl >> 4, c2 = cl & 15; float x = 0.f;
                  if (s <= t) x += kf[(0 * 16 + (t - s)) * 256 + c * 16 + c2];
                  if (s >= t) x += kf[(1 * 16 + (s - t)) * 256 + c * 16 + c2];
                  if (s == t && c == c2) x += in[I_SD][l * 512 + g * 16 + c];
                  v[e] = x; }
                { const int t = row >> 4, c = row & 15, d = cl >> 7, im = (cl >> 6) & 1, p = cl & 63, tau = d == 0 ? t + 1 : 16 - t;
                  const float cr = cc[((d * 16 + c) * 64 + p) * 2], ci = cc[((d * 16 + c) * 64 + p) * 2 + 1], ar = pw[((d * 17 + tau) * 64 + p) * 2], ai = pw[((d * 17 + tau) * 64 + p) * 2 + 1];
                  w[e] = im ? -(cr * ai + ci * ar) : (cr * ar - ci * ai); }
                { const int d = row >> 7, im = (row >> 6) & 1, p = row & 63, s = cl >> 4, c2 = cl & 15, tau = d == 0 ? 15 - s : s;
                  const float ar = pw[((d * 17 + tau) * 64 + p) * 2], ai = pw[((d * 17 + tau) * 64 + p) * 2 + 1], br = bb[((d * 64 + p) * 16 + c2) * 2], bi = bb[((d * 64 + p) * 16 + c2) * 2 + 1];
                  z[e] = im ? (ar * bi + ai * br) : (ar * br - ai * bi); } }
            *(unsigned*)(KM + (size_t)row * 256 + col) = pk2(v[0], v[1]);
            *(unsigned*)(CM + (size_t)row * 256 + col) = pk2(w[0], w[1]);
            *(unsigned*)(BMp + (size_t)row * 256 + col) = pk2(z[0], z[1]);
        }
    }
    __syncthreads();
}
__device__ __forceinline__ void norm_phase(const float* xp, const float* xs, bf16_t* XB, bool first, const float* gain, const float* modl, int sh_idx, int sc_idx, bf16_t* H, int gw, int NGW, int lane) {
    for (int row = gw; row < MTOK; row += NGW) {
        f32x4 v[8]; float ss = 0.f;
        if (first) { const float* src = row < MCTX ? xp + (size_t)row * D : xs + (size_t)(row - MCTX) * D;
#pragma unroll
            for (int j = 0; j < 4; ++j) { v[2 * j] = *(const f32x4*)(src + 8 * (lane + 64 * j)); v[2 * j + 1] = *(const f32x4*)(src + 8 * (lane + 64 * j) + 4); }
#pragma unroll
            for (int j = 0; j < 4; ++j) { u32x4 w; w.x = pk2(v[2 * j][0], v[2 * j][1]); w.y = pk2(v[2 * j][2], v[2 * j][3]); w.z = pk2(v[2 * j + 1][0], v[2 * j + 1][1]); w.w = pk2(v[2 * j + 1][2], v[2 * j + 1][3]);
                *(u32x4*)(XB + (size_t)row * D + 8 * (lane + 64 * j)) = w;
                v[2 * j] = (f32x4){bflo(w.x), bfhi(w.x), bflo(w.y), bfhi(w.y)}; v[2 * j + 1] = (f32x4){bflo(w.z), bfhi(w.z), bflo(w.w), bfhi(w.w)}; } }
        else {
#pragma unroll
            for (int j = 0; j < 4; ++j) { const u32x4 w = *(const u32x4*)(XB + (size_t)row * D + 8 * (lane + 64 * j));
                v[2 * j] = (f32x4){bflo(w.x), bfhi(w.x), bflo(w.y), bfhi(w.y)}; v[2 * j + 1] = (f32x4){bflo(w.z), bfhi(w.z), bflo(w.w), bfhi(w.w)}; } }
#pragma unroll
        for (int j = 0; j < 8; ++j) ss += (v[j][0] * v[j][0] + v[j][1] * v[j][1]) + (v[j][2] * v[j][2] + v[j][3] * v[j][3]);
#pragma unroll
        for (int o = 1; o < 64; o <<= 1) ss += __shfl_xor(ss, o);
        const float rstd = rsqrtf(ss * (1.0f / D) + EPS);
        const int r = row < MCTX ? 0 : 1 + ((row - MCTX) >> 11);
        const float* mp = modl + (size_t)r * 12288;
#pragma unroll
        for (int j = 0; j < 4; ++j) { const int col = 8 * (lane + 64 * j); u32x4 w;
#pragma unroll
            for (int h2 = 0; h2 < 2; ++h2) { const int c4 = col + 4 * h2;
                const f32x4 g4 = *(const f32x4*)(gain + c4), sc4 = *(const f32x4*)(mp + sc_idx * 2048 + c4), sh4 = *(const f32x4*)(mp + sh_idx * 2048 + c4);
                const f32x4 y = v[2 * j + h2] * rstd * g4 * (sc4 + 1.0f) + sh4;
                if (h2 == 0) { w.x = pk2(y[0], y[1]); w.y = pk2(y[2], y[3]); } else { w.z = pk2(y[0], y[1]); w.w = pk2(y[2], y[3]); } }
            *(u32x4*)(H + (size_t)row * D + col) = w; }
    }
}

__device__ __forceinline__ void m1_attn_prep(bf16_t* PROJ, const float* qn, const float* kn, float* out, int l, int gtid, int NT) {
    for (int idx = gtid; idx < MTOK * 128; idx += NT) {
        const int part = idx & 15, hs = (idx >> 4) & 7, row = idx >> 7; const bool ctx = row < MCTX;
        if (hs >= 6 && !ctx) continue;
        const int col = (hs < 4 ? C_AQ + hs * 128 : hs < 6 ? C_AK + (hs - 4) * 128 : C_AV + (hs - 6) * 128) + part * 8;
        bf16_t* p = PROJ + (size_t)row * NPROJ + col;
        const u32x4 w = *(const u32x4*)p;
        float x[8] = {bflo(w.x), bfhi(w.x), bflo(w.y), bfhi(w.y), bflo(w.z), bfhi(w.z), bflo(w.w), bfhi(w.w)};
        if (hs >= 6) { float* o = out + O_NV + ((size_t)((row >> 8) * 4 + l) * 256 + (row & 255)) * 256 + (hs - 6) * 128 + part * 8;
            *(f32x4*)o = (f32x4){x[0], x[1], x[2], x[3]}; *(f32x4*)(o + 4) = (f32x4){x[4], x[5], x[6], x[7]}; continue; }
        float ss = 0.f;
#pragma unroll
        for (int e = 0; e < 8; ++e) ss += x[e] * x[e];
        ss += __shfl_xor(ss, 1); ss += __shfl_xor(ss, 2); ss += __shfl_xor(ss, 4); ss += __shfl_xor(ss, 8);
        const float rstd = rsqrtf(ss * (1.0f / 128.0f) + EPS);
        const float* gn = (hs < 4 ? qn : kn) + part * 8;
#pragma unroll
        for (int e = 0; e < 8; ++e) x[e] = x[e] * rstd * gn[e];
        if (ctx) { if (hs >= 4) { float* o = out + O_NK + ((size_t)((row >> 8) * 4 + l) * 256 + (row & 255)) * 256 + (hs - 4) * 128 + part * 8;
                *(f32x4*)o = (f32x4){x[0], x[1], x[2], x[3]}; *(f32x4*)(o + 4) = (f32x4){x[4], x[5], x[6], x[7]}; } }
        else { const int t = (row - MCTX) & 2047; const float rp = (float)(t >> 6), cp = (float)(t & 63);
#pragma unroll
            for (int e = 0; e < 8; ++e) { const float other = __shfl_xor(x[e], 8); const int i = (part & 7) * 8 + e; const float pos = i < 32 ? rp : cp;
                float rev = pos * __builtin_amdgcn_exp2f(-(float)(i & 31) * 0.41524101186092029f) * 0.15915494309189535f; rev -= rintf(rev);
                const float cs = __builtin_amdgcn_cosf(rev), sn = __builtin_amdgcn_sinf(rev);
                x[e] = part < 8 ? x[e] * cs - other * sn : x[e] * cs + other * sn; } }
        u32x4 o; o.x = pk2(x[0], x[1]); o.y = pk2(x[2], x[3]); o.z = pk2(x[4], x[5]); o.w = pk2(x[6], x[7]);
        *(u32x4*)p = o;
    }
}
__device__ __forceinline__ void m1_lru_conv(const bf16_t* PROJ, bf16_t* XC, const float* cw, const float* cb, int gtid, int NT) {
    for (int idx = gtid; idx < MTOK * 64; idx += NT) {
        const int row = idx >> 6, c8 = (idx & 63) * 8;
        const int t = row < MCTX ? (row & 255) : ((row - MCTX) & 2047), L = row < MCTX ? 256 : 2048;
        float a[8];
#pragma unroll
        for (int e = 0; e < 8; ++e) a[e] = cb[c8 + e];
#pragma unroll
        for (int j = 0; j < 4; ++j) { const int tt = t - 2 + j;
            if (tt >= 0 && tt < L) { const u32x4 w = *(const u32x4*)(PROJ + (size_t)(row - 2 + j) * NPROJ + C_LX + c8);
                const float x[8] = {bflo(w.x), bfhi(w.x), bflo(w.y), bfhi(w.y), bflo(w.z), bfhi(w.z), bflo(w.w), bfhi(w.w)};
#pragma unroll
                for (int e = 0; e < 8; ++e) a[e] += cw[j * 512 + c8 + e] * x[e]; } }
        u32x4 o; o.x = pk2(a[0], a[1]); o.y = pk2(a[2], a[3]); o.z = pk2(a[4], a[5]); o.w = pk2(a[6], a[7]);
        *(u32x4*)(XC + (size_t)row * 512 + c8) = o;
    }
}
__device__ __forceinline__ void m1_ssm_bu(const bf16_t* PROJ, const bf16_t* BMl, float* BU, int unit, int wave, int lane) {
    const int g = unit >> 3, bt0 = (unit & 7) * 12, fr = lane & 15, G4 = lane >> 4;
    const bf16_t* BMg = BMl + (size_t)g * 65536;
    bf16x8 af[2][8];
#pragma unroll
    for (int qi = 0; qi < 2; ++qi)
#pragma unroll
        for (int ks = 0; ks < 8; ++ks) af[qi][ks] = *(const bf16x8*)(BMg + (size_t)((2 * wave + qi) * 16 + fr) * 256 + ks * 32 + G4 * 8);
    for (int bt = bt0; bt < bt0 + 12; ++bt) {
        const int chunk = bt * 16 + fr;
        const bf16_t* up = PROJ + (size_t)(chunk * 16 + (G4 >> 1)) * NPROJ + C_SU + 16 * g + 8 * (G4 & 1);
        f32x4 acc[2] = {(f32x4){0.f, 0.f, 0.f, 0.f}, (f32x4){0.f, 0.f, 0.f, 0.f}};
#pragma unroll
        for (int ks = 0; ks < 8; ++ks) { const bf16x8 b = *(const bf16x8*)(up + (size_t)(2 * ks) * NPROJ);
            acc[0] = mfma16(af[0][ks], b, acc[0]); acc[1] = mfma16(af[1][ks], b, acc[1]); }
#pragma unroll
        for (int qi = 0; qi < 2; ++qi) *(f32x4*)(BU + ((size_t)g * NCHUNK16 + chunk) * 256 + (2 * wave + qi) * 16 + 4 * G4) = acc[qi];
    }
}
__device__ __forceinline__ float ret_log2gamma(float logit) { return -log1pf(__expf(-logit)) * LOG2E; }
__device__ __forceinline__ void m1_ret_kv(const bf16_t* PROJ, float* KV, const float* decl, LAS unsigned char* lds, int unit, int tid, int wave, int lane) {
    const int cn = unit >> 2, hh = unit & 3, fr = lane & 15, G4 = lane >> 4;
    LAS unsigned char* Ks = lds; LAS unsigned char* Vf = lds + 128 * 288; LAS unsigned char* Vb = lds + 2 * 128 * 288;
    const float lgf = ret_log2gamma(decl[hh]), lgb = ret_log2gamma(decl[4 + hh]);
    const size_t row0 = (size_t)cn * 128;
    __syncthreads();
    stage_rows<128>(Ks, 288, PROJ + row0 * NPROJ + C_RK + hh * 128, NPROJ, tid);
#pragma unroll
    for (int c = tid; c < 128 * 16; c += 512) { const int j = c >> 4, ch = c & 15; const u32x4 w = *(const u32x4*)(PROJ + (row0 + j) * NPROJ + C_RV + hh * 128 + ch * 8);
        const float wf = __builtin_amdgcn_exp2f((float)(127 - j) * lgf), wb = __builtin_amdgcn_exp2f((float)j * lgb);
        const float x[8] = {bflo(w.x), bfhi(w.x), bflo(w.y), bfhi(w.y), bflo(w.z), bfhi(w.z), bflo(w.w), bfhi(w.w)};
        u32x4 o; o.x = pk2(x[0] * wf, x[1] * wf); o.y = pk2(x[2] * wf, x[3] * wf); o.z = pk2(x[4] * wf, x[5] * wf); o.w = pk2(x[6] * wf, x[7] * wf);
        *(LAS u32x4*)(Vf + j * 288 + ch * 16) = o;
        o.x = pk2(x[0] * wb, x[1] * wb); o.y = pk2(x[2] * wb, x[3] * wb); o.z = pk2(x[4] * wb, x[5] * wb); o.w = pk2(x[6] * wb, x[7] * wb);
        *(LAS u32x4*)(Vb + j * 288 + ch * 16) = o; }
    __syncthreads();
    f32x4 af[8], ab[8];
#pragma unroll
    for (int nt = 0; nt < 8; ++nt) { af[nt] = (f32x4){0.f, 0.f, 0.f, 0.f}; ab[nt] = (f32x4){0.f, 0.f, 0.f, 0.f}; }
#pragma unroll
    for (int ks = 0; ks < 4; ++ks) {
        const bf16x8 a = frag_tr(Ks, 288, 32 * ks + 8 * G4, 32 * ks + 8 * G4 + 4, 16 * wave, lane);
#pragma unroll
        for (int nt = 0; nt < 8; ++nt) { const bf16x8 bf = frag_tr(Vf, 288, 32 * ks + 8 * G4, 32 * ks + 8 * G4 + 4, 16 * nt, lane), bb = frag_tr(Vb, 288, 32 * ks + 8 * G4, 32 * ks + 8 * G4 + 4, 16 * nt, lane);
            af[nt] = mfma16(a, bf, af[nt]); ab[nt] = mfma16(a, bb, ab[nt]); }
    }
    float* base = KV + (size_t)((cn * 4 + hh) * 2) * 16384;
#pragma unroll
    for (int nt = 0; nt < 8; ++nt) { *(f32x4*)(base + (size_t)(16 * nt + fr) * 128 + 16 * wave + 4 * G4) = af[nt]; *(f32x4*)(base + 16384 + (size_t)(16 * nt + fr) * 128 + 16 * wave + 4 * G4) = ab[nt]; }
}

__device__ __forceinline__ void m2_attn_unit(const bf16_t* PROJ, const float* ck, const float* cv, bf16_t* O, const float* sink, LAS unsigned char* lds, int u, int l, int tid, int wave, int lane) {
    const int fr = lane & 15, G4 = lane >> 4;
    const bool lat = u >= 256; int seq, kvh, qb; size_t rbase;
    if (!lat) { seq = u >> 3; kvh = (u >> 2) & 1; qb = u & 3; rbase = (size_t)seq * 256; }
    else { const int v = u - 256; seq = v >> 6; kvh = (v >> 5) & 1; qb = v & 31; rbase = (size_t)MCTX + (size_t)seq * 2048; }
    const int head = 2 * kvh + (wave >> 2), qq = (wave & 3) * 16 + fr;
    LAS unsigned char* Ks = lds; LAS unsigned char* Vs = lds + 64 * 272;
    bf16x8 qf[4];
    { const bf16_t* qp = PROJ + (rbase + qb * 64 + qq) * NPROJ + C_AQ + head * 128 + G4 * 8;
#pragma unroll
      for (int ks = 0; ks < 4; ++ks) qf[ks] = *(const bf16x8*)(qp + ks * 32); }
    float mrun = sink[head] * LOG2E, lsum = G4 == 0 ? 1.0f : 0.0f;
    f32x4 oacc[8];
#pragma unroll
    for (int mt = 0; mt < 8; ++mt) oacc[mt] = (f32x4){0.f, 0.f, 0.f, 0.f};
    const float SC2 = 0.08838834764831845f * LOG2E;
    const int ntile = lat ? 9 : 4;
    for (int it = 0; it < ntile; ++it) {
        int kind = 0, mask = 0; size_t krow0 = 0; int p0 = 0;
        if (!lat) krow0 = rbase + 64 * it;
        else if (it < 5) { const int tb = qb - 2 + it; if (tb < 0 || tb >= 32) continue; krow0 = rbase + 64 * tb; mask = it == 0 ? 1 : it == 4 ? 2 : 0; }
        else { kind = 1; p0 = 64 * (it - 5); }
        __syncthreads();
        if (kind == 0) { stage_rows<64>(Ks, 272, PROJ + krow0 * NPROJ + C_AK + kvh * 128, NPROJ, tid); stage_rows<64>(Vs, 288, PROJ + krow0 * NPROJ + C_AV + kvh * 128, NPROJ, tid); }
        else {
#pragma unroll
            for (int c = tid; c < 64 * 16; c += 512) { const int j = c >> 4, ch = c & 15; const size_t off = ((size_t)((seq * 4 + l) * 256 + p0 + j)) * 256 + kvh * 128 + ch * 8;
                const f32x4 k0 = *(const f32x4*)(ck + off), k1 = *(const f32x4*)(ck + off + 4), v0 = *(const f32x4*)(cv + off), v1 = *(const f32x4*)(cv + off + 4);
                u32x4 o; o.x = pk2(k0[0], k0[1]); o.y = pk2(k0[2], k0[3]); o.z = pk2(k1[0], k1[1]); o.w = pk2(k1[2], k1[3]); *(LAS u32x4*)(Ks + j * 272 + ch * 16) = o;
                o.x = pk2(v0[0], v0[1]); o.y = pk2(v0[2], v0[3]); o.z = pk2(v1[0], v1[1]); o.w = pk2(v1[2], v1[3]); *(LAS u32x4*)(Vs + j * 288 + ch * 16) = o; } }
        __syncthreads();
        f32x4 sa[4];
#pragma unroll
        for (int nt = 0; nt < 4; ++nt) { sa[nt] = (f32x4){0.f, 0.f, 0.f, 0.f};
#pragma unroll
            for (int ks = 0; ks < 4; ++ks) sa[nt] = mfma16(*(const LAS bf16x8*)(Ks + (nt * 16 + fr) * 272 + (ks * 32 + G4 * 8) * 2), qf[ks], sa[nt]); }
        float tmax = -3.0e38f;
#pragma unroll
        for (int nt = 0; nt < 4; ++nt)
#pragma unroll
            for (int r = 0; r < 4; ++r) { const int jj = 16 * nt + 4 * G4 + r; float s = sa[nt][r] * SC2;
                if (mask == 1 && jj < qq) s = -3.0e38f; if (mask == 2 && jj > qq) s = -3.0e38f; sa[nt][r] = s; tmax = fmaxf(tmax, s); }
        tmax = fmaxf(tmax, __shfl_xor(tmax, 16)); tmax = fmaxf(tmax, __shfl_xor(tmax, 32));
        const float mnew = fmaxf(mrun, tmax), alpha = __builtin_amdgcn_exp2f(mrun - mnew); mrun = mnew;
        float ps = 0.f;
#pragma unroll
        for (int nt = 0; nt < 4; ++nt)
#pragma unroll
            for (int r = 0; r < 4; ++r) { const float p = __builtin_amdgcn_exp2f(sa[nt][r] - mnew); sa[nt][r] = p; ps += p; }
        lsum = lsum * alpha + ps;
        const bf16x8 pf0 = pack8(sa[0], sa[1]), pf1 = pack8(sa[2], sa[3]);
#pragma unroll
        for (int mt = 0; mt < 8; ++mt) { oacc[mt] = oacc[mt] * alpha;
            oacc[mt] = mfma16(frag_tr(Vs, 288, 4 * G4, 16 + 4 * G4, 16 * mt, lane), pf0, oacc[mt]);
            oacc[mt] = mfma16(frag_tr(Vs, 288, 32 + 4 * G4, 48 + 4 * G4, 16 * mt, lane), pf1, oacc[mt]); }
    }
    lsum += __shfl_xor(lsum, 16); lsum += __shfl_xor(lsum, 32);
    const float inv = 1.0f / lsum;
    bf16_t* op = O + (rbase + qb * 64 + qq) * D + 1024 + head * 128 + 4 * G4;
#pragma unroll
    for (int mt = 0; mt < 8; ++mt) { u32x2 w; w.x = pk2(oacc[mt][0] * inv, oacc[mt][1] * inv); w.y = pk2(oacc[mt][2] * inv, oacc[mt][3] * inv); *(u32x2*)(op + 16 * mt) = w; }
}
__device__ __forceinline__ void m2_ssm_scan(const float* BU, bf16_t* HS, const float* A16l, const float* sre, const float* sim, float* out, int l, int item, int tid) {
    const int seq = item >> 3, g = (item & 7) * 4 + (tid >> 7), c = tid & 127, dir = c >> 6, p = c & 63;
    const bool lat = seq >= 32; const int chunk0 = lat ? 512 + (seq - 32) * 128 : seq * 16, N = lat ? 128 : 16;
    const float ar = A16l[((dir * 32 + g) * 64 + p) * 2], ai = A16l[((dir * 32 + g) * 64 + p) * 2 + 1];
    float hr = 0.f, hi = 0.f;
    if (lat) { const size_t ix = ((size_t)(((seq - 32) * 4 + l) * 2 + dir) * 32 + g) * 64 + p; hr = sre[ix]; hi = sim[ix]; }
    const long step = dir == 0 ? 1 : -1; const int cfirst = chunk0 + (dir == 0 ? 0 : N - 1);
    const float* bp = BU + ((size_t)g * NCHUNK16 + cfirst) * 256 + dir * 128 + p;
    bf16_t* hp = HS + ((size_t)cfirst * 32 + g) * 256 + dir * 128 + p;
    for (int s0 = 0; s0 < N; s0 += 16) {
        float br[16], bi[16];
#pragma unroll
        for (int k = 0; k < 16; ++k) { br[k] = bp[(long)(s0 + k) * step * 256]; bi[k] = bp[(long)(s0 + k) * step * 256 + 64]; }
#pragma unroll
        for (int k = 0; k < 16; ++k) { bf16_t* h2 = hp + (long)(s0 + k) * step * 8192; h2[0] = (bf16_t)(pk2(hr, 0.f) & 0xffffu); h2[64] = (bf16_t)(pk2(hi, 0.f) & 0xffffu);
            const float nr = ar * hr - ai * hi + br[k], ni = ar * hi + ai * hr + bi[k]; hr = nr; hi = ni; }
    }
    if (!lat) { const size_t ix = ((size_t)((seq * 4 + l) * 2 + dir) * 32 + g) * 64 + p; out[O_NSRE + ix] = hr; out[O_NSIM + ix] = hi; }
}
template <int N> __device__ __forceinline__ f32x4 ret_scan_run(const float* KV, bf16_t* SIN, f32x4 S, float g128, int c0, int dir, size_t inner) {
    f32x4 kv[N];
#pragma unroll
    for (int st = 0; st < N; ++st) { const int cn = c0 + (dir == 0 ? st : N - 1 - st); kv[st] = *(const f32x4*)(KV + (size_t)cn * 131072 + inner); }
#pragma unroll
    for (int st = 0; st < N; ++st) { const int cn = c0 + (dir == 0 ? st : N - 1 - st); u32x2 w; w.x = pk2(S[0], S[1]); w.y = pk2(S[2], S[3]); *(u32x2*)(SIN + (size_t)cn * 131072 + inner) = w; S = S * g128 + kv[st]; }
    return S;
}
__device__ __forceinline__ void m2_ret_scan(const float* KV, bf16_t* SIN, const float* sret, const float* decl, float* out, int l, int gtid, int NT) {
    for (int idx = gtid; idx < 40 * 4 * 2 * 128 * 32; idx += NT) {
        const int dk4 = (idx & 31) * 4, dv = (idx >> 5) & 127, dir = (idx >> 12) & 1, hh = (idx >> 13) & 3, seq = idx >> 15;
        const bool lat = seq >= 32; const int c0 = lat ? 64 + (seq - 32) * 16 : seq * 2;
        const float g128 = __builtin_amdgcn_exp2f(128.0f * ret_log2gamma(decl[dir * 4 + hh]));
        const size_t inner = (size_t)(hh * 2 + dir) * 16384 + (size_t)dv * 128 + dk4;
        f32x4 S = (f32x4){0.f, 0.f, 0.f, 0.f};
        if (lat) { const float* sp = sret + ((size_t)((((seq - 32) * 4 + l) * 2 + dir) * 4 + hh) * 128 + dk4) * 128 + dv; S = (f32x4){sp[0], sp[128], sp[256], sp[384]};
            S = ret_scan_run<16>(KV, SIN, S, g128, c0, dir, inner); }
        else { S = ret_scan_run<2>(KV, SIN, S, g128, c0, dir, inner);
            float* op = out + O_NRET + ((size_t)(((seq * 4 + l) * 2 + dir) * 4 + hh) * 128 + dk4) * 128 + dv; op[0] = S[0]; op[128] = S[1]; op[256] = S[2]; op[384] = S[3]; }
    }
}

template <int T> __device__ __forceinline__ void lru_task(const bf16_t* LA, const bf16_t* LB, const bf16_t* PROJ, bf16_t* O, const float* slru, float* out, LAS unsigned char* lds, int l, bool lat, int seq, int cg, size_t rbase, int tid, int wave, int lane) {
    constexpr int TB = T < 16 ? T : 16;
    const int chl = lane & 15, seg = wave * 4 + (lane >> 4), ch = cg * 16 + chl;
    LAS float* sA = (LAS float*)lds;
    LAS float* sH = sA + 1024;
    LAS float* hl = (LAS float*)(lds + 8192) + tid;
    const bf16_t* pa = LA + (rbase + (size_t)seg * T) * 1024 + ch; const bf16_t* pb = LB + (rbase + (size_t)seg * T) * 1024 + ch;
    float As = 0.f, hf = 0.f, Ab = 0.f, hb = 0.f;
#pragma unroll 1
    for (int t0 = 0; t0 < T; t0 += TB) { unsigned short ra[TB], rb[TB]; const bf16_t* qa = pa + (size_t)t0 * 1024; const bf16_t* qb = pb + (size_t)t0 * 1024;
#pragma unroll
        for (int k = 0; k < TB; ++k) { ra[k] = qa[k * 1024]; rb[k] = qb[k * 1024]; }
#pragma unroll
        for (int k = 0; k < TB; ++k) { const float la = bf2f(ra[k]); hf = __builtin_amdgcn_exp2f(la) * hf + bf2f(rb[k]); As += la; } }
#pragma unroll 1
    for (int t0 = T - TB; t0 >= 0; t0 -= TB) { unsigned short ra[TB], rb[TB]; const bf16_t* qa = pa + (size_t)t0 * 1024 + 512; const bf16_t* qb = pb + (size_t)t0 * 1024 + 512;
#pragma unroll
        for (int k = 0; k < TB; ++k) { ra[k] = qa[k * 1024]; rb[k] = qb[k * 1024]; }
#pragma unroll
        for (int k = TB - 1; k >= 0; --k) { const float la = bf2f(ra[k]); hb = __builtin_amdgcn_exp2f(la) * hb + bf2f(rb[k]); Ab += la; } }
    __syncthreads();
    sA[seg * 16 + chl] = As; sH[seg * 16 + chl] = hf; sA[512 + seg * 16 + chl] = Ab; sH[512 + seg * 16 + chl] = hb;
    __syncthreads();
    float hinf = 0.f, hinb = 0.f;
    if (lat) { hinf = slru[(size_t)(((seq - 32) * 4 + l) * 2 + 0) * 512 + ch]; hinb = slru[(size_t)(((seq - 32) * 4 + l) * 2 + 1) * 512 + ch]; }
    for (int s = 0; s < seg; ++s) hinf = __builtin_amdgcn_exp2f(sA[s * 16 + chl]) * hinf + sH[s * 16 + chl];
    for (int s = 31; s > seg; --s) hinb = __builtin_amdgcn_exp2f(sA[512 + s * 16 + chl]) * hinb + sH[512 + s * 16 + chl];
    float h = hinf;
#pragma unroll 1
    for (int t0 = 0; t0 < T; t0 += TB) { unsigned short ra[TB], rb[TB]; const bf16_t* qa = pa + (size_t)t0 * 1024; const bf16_t* qb = pb + (size_t)t0 * 1024;
#pragma unroll
        for (int k = 0; k < TB; ++k) { ra[k] = qa[k * 1024]; rb[k] = qb[k * 1024]; }
#pragma unroll
        for (int k = 0; k < TB; ++k) { h = __builtin_amdgcn_exp2f(bf2f(ra[k])) * h + bf2f(rb[k]); hl[(t0 + k) * 512] = h; } }
    if (!lat && seg == 31) out[O_NLRU + (size_t)((seq * 4 + l) * 2 + 0) * 512 + ch] = h;
    h = hinb;
    const bf16_t* pg = PROJ + (rbase + (size_t)seg * T) * NPROJ + C_LG + ch; bf16_t* po = O + (rbase + (size_t)seg * T) * D + 512 + ch;
#pragma unroll 1
    for (int t0 = T - TB; t0 >= 0; t0 -= TB) { unsigned short ra[TB], rb[TB], rg[TB]; const bf16_t* qa = pa + (size_t)t0 * 1024 + 512; const bf16_t* qb = pb + (size_t)t0 * 1024 + 512; const bf16_t* qg = pg + (size_t)t0 * NPROJ; bf16_t* qo = po + (size_t)t0 * D;
#pragma unroll
        for (int k = 0; k < TB; ++k) { ra[k] = qa[k * 1024]; rb[k] = qb[k * 1024]; rg[k] = qg[k * NPROJ]; }
#pragma unroll
        for (int k = TB - 1; k >= 0; --k) { h = __builtin_amdgcn_exp2f(bf2f(ra[k])) * h + bf2f(rb[k]);
            const float y = gelu_tanh(bf2f(rg[k])) * (hl[(t0 + k) * 512] + h); qo[k * D] = (bf16_t)(pk2(y, 0.f) & 0xffffu); } }
    if (!lat && seg == 0) out[O_NLRU + (size_t)((seq * 4 + l) * 2 + 1) * 512 + ch] = h;
}
__device__ __forceinline__ void m3_lru_scan(const bf16_t* LA, const bf16_t* LB, const bf16_t* PROJ, bf16_t* O, const float* slru, float* out, LAS unsigned char* lds, int l, int task, int tid, int wave, int lane) {
    if (task < 256) { const int seq = 32 + (task >> 5); lru_task<64>(LA, LB, PROJ, O, slru, out, lds, l, true, seq, task & 31, (size_t)MCTX + (size_t)(seq - 32) * 2048, tid, wave, lane); }
    else { const int t2 = task - 256, seq = t2 >> 5; lru_task<8>(LA, LB, PROJ, O, slru, out, lds, l, false, seq, t2 & 31, (size_t)seq * 256, tid, wave, lane); }
}
__device__ __forceinline__ void m3_ssm_y(const bf16_t* PROJ, const bf16_t* KMl, const bf16_t* CMl, const bf16_t* HS, bf16_t* YS, int unit, int wave, int lane) {
    const int g = unit >> 3, bt0 = (unit & 7) * 12, fr = lane & 15, G4 = lane >> 4;
    const bf16_t* KMg = KMl + (size_t)g * 65536; const bf16_t* CMg = CMl + (size_t)g * 65536;
    bf16x8 kf[2][8], cf[2][8];
#pragma unroll
    for (int qi = 0; qi < 2; ++qi)
#pragma unroll
        for (int ks = 0; ks < 8; ++ks) { kf[qi][ks] = *(const bf16x8*)(KMg + (size_t)((2 * wave + qi) * 16 + fr) * 256 + ks * 32 + G4 * 8); cf[qi][ks] = *(const bf16x8*)(CMg + (size_t)((2 * wave + qi) * 16 + fr) * 256 + ks * 32 + G4 * 8); }
    for (int bt = bt0; bt < bt0 + 12; ++bt) {
        const int chunk = bt * 16 + fr;
        const bf16_t* up = PROJ + (size_t)(chunk * 16 + (G4 >> 1)) * NPROJ + C_SU + 16 * g + 8 * (G4 & 1);
        const bf16_t* hp = HS + ((size_t)chunk * 32 + g) * 256 + G4 * 8;
        f32x4 acc[2] = {(f32x4){0.f, 0.f, 0.f, 0.f}, (f32x4){0.f, 0.f, 0.f, 0.f}};
#pragma unroll
        for (int ks = 0; ks < 8; ++ks) { const bf16x8 bu = *(const bf16x8*)(up + (size_t)(2 * ks) * NPROJ), bh = *(const bf16x8*)(hp + ks * 32);
            acc[0] = mfma16(kf[0][ks], bu, acc[0]); acc[1] = mfma16(kf[1][ks], bu, acc[1]); acc[0] = mfma16(cf[0][ks], bh, acc[0]); acc[1] = mfma16(cf[1][ks], bh, acc[1]); }
#pragma unroll
        for (int qi = 0; qi < 2; ++qi) { const int t = 2 * wave + qi; u32x2 w; w.x = pk2(gelu_tanh(acc[qi][0]), gelu_tanh(acc[qi][1])); w.y = pk2(gelu_tanh(acc[qi][2]), gelu_tanh(acc[qi][3]));
            *(u32x2*)(YS + (size_t)(chunk * 16 + t) * 512 + g * 16 + 4 * G4) = w; }
    }
}
__device__ __forceinline__ void m3_ret_out(const bf16_t* PROJ, const bf16_t* SIN, bf16_t* O, const float* decl, const float* gnl, LAS unsigned char* lds, int unit, int tid, int wave, int lane) {
    const int cn = unit >> 2, hh = unit & 3, fr = lane & 15, G4 = lane >> 4;
    LAS unsigned char* Ks = lds; LAS unsigned char* Vs = lds + 128 * 272;
    const size_t row0 = (size_t)cn * 128;
    const float lgf = ret_log2gamma(decl[hh]), lgb = ret_log2gamma(decl[4 + hh]), scale = 0.08838834764831845f;
    __syncthreads();
    stage_rows<128>(Ks, 272, PROJ + row0 * NPROJ + C_RK + hh * 128, NPROJ, tid);
    stage_rows<128>(Vs, 288, PROJ + row0 * NPROJ + C_RV + hh * 128, NPROJ, tid);
    const int i = wave * 16 + fr;
    bf16x8 qf[4];
    { const bf16_t* qp = PROJ + (row0 + i) * NPROJ + C_RQ + hh * 128 + G4 * 8;
#pragma unroll
      for (int ks = 0; ks < 4; ++ks) qf[ks] = *(const bf16x8*)(qp + ks * 32); }
    __syncthreads();
    bf16x8 pf[4];
    {   f32x4 sa[8];
#pragma unroll
        for (int jt = 0; jt < 8; ++jt) { sa[jt] = (f32x4){0.f, 0.f, 0.f, 0.f};
#pragma unroll
            for (int ks = 0; ks < 4; ++ks) sa[jt] = mfma16(*(const LAS bf16x8*)(Ks + (jt * 16 + fr) * 272 + (ks * 32 + G4 * 8) * 2), qf[ks], sa[jt]); }
#pragma unroll
        for (int jt = 0; jt < 8; ++jt)
#pragma unroll
            for (int r = 0; r < 4; ++r) { const int dlt = i - (16 * jt + 4 * G4 + r); float f = 0.f;
                if (dlt >= 0) f += __builtin_amdgcn_exp2f((float)dlt * lgf); if (dlt <= 0) f += __builtin_amdgcn_exp2f((float)(-dlt) * lgb); sa[jt][r] *= f * scale; }
#pragma unroll
        for (int s = 0; s < 4; ++s) pf[s] = pack8(sa[2 * s], sa[2 * s + 1]);
    }
    const float wfi = __builtin_amdgcn_exp2f((float)(i + 1) * lgf) * scale, wbi = __builtin_amdgcn_exp2f((float)(128 - i) * lgb) * scale;
    const bf16_t* Sf = SIN + (size_t)((cn * 4 + hh) * 2) * 16384 + (size_t)fr * 128 + G4 * 8; const bf16_t* Sb = Sf + 16384;
    f32x4 o[8]; float sum = 0.f;
#pragma unroll
    for (int mt = 0; mt < 8; ++mt) {
        f32x4 oi = (f32x4){0.f, 0.f, 0.f, 0.f}, of = oi, ob = oi;
#pragma unroll
        for (int s = 0; s < 4; ++s) { oi = mfma16(frag_tr(Vs, 288, 32 * s + 4 * G4, 32 * s + 16 + 4 * G4, 16 * mt, lane), pf[s], oi);
            of = mfma16(*(const bf16x8*)(Sf + (size_t)mt * 2048 + s * 32), qf[s], of); ob = mfma16(*(const bf16x8*)(Sb + (size_t)mt * 2048 + s * 32), qf[s], ob); }
        o[mt] = oi + of * wfi + ob * wbi; sum += (o[mt][0] + o[mt][1]) + (o[mt][2] + o[mt][3]);
    }
    sum += __shfl_xor(sum, 16); sum += __shfl_xor(sum, 32);
    const float mu = sum * (1.0f / 128.0f); float q = 0.f;
#pragma unroll
    for (int mt = 0; mt < 8; ++mt) { o[mt] = o[mt] - mu; q += (o[mt][0] * o[mt][0] + o[mt][1] * o[mt][1]) + (o[mt][2] * o[mt][2] + o[mt][3] * o[mt][3]); }
    q += __shfl_xor(q, 16); q += __shfl_xor(q, 32);
    const float rstd = rsqrtf(q * (1.0f / 128.0f) + EPS);
#pragma unroll
    for (int mt = 0; mt < 8; ++mt) { const int dv0 = 16 * mt + 4 * G4; const f32x4 gn4 = *(const f32x4*)(gnl + hh * 128 + dv0);
        const u32x2 gw = *(const u32x2*)(PROJ + (row0 + i) * NPROJ + C_RG + hh * 128 + dv0);
        const float g0 = siluf_(bflo(gw.x)), g1 = siluf_(bfhi(gw.x)), g2 = siluf_(bflo(gw.y)), g3 = siluf_(bfhi(gw.y));
        u32x2 w; w.x = pk2(o[mt][0] * rstd * gn4[0] * g0, o[mt][1] * rstd * gn4[1] * g1); w.y = pk2(o[mt][2] * rstd * gn4[2] * g2, o[mt][3] * rstd * gn4[3] * g3);
        *(u32x2*)(O + (row0 + i) * D + hh * 128 + dv0) = w; }
}
#ifndef REP_M1A
#define REP_M1A 1
#endif
#ifndef REP_M1B
#define REP_M1B 1
#endif
#ifndef REP_M1C
#define REP_M1C 1
#endif
#ifndef REP_M2A
#define REP_M2A 1
#endif
#ifndef REP_M2B
#define REP_M2B 1
#endif
#ifndef REP_M2C
#define REP_M2C 1
#endif
#ifndef REP_M2D
#define REP_M2D 1
#endif
#ifndef REP_M3A
#define REP_M3A 1
#endif
#ifndef REP_M3B
#define REP_M3B 1
#endif
#ifndef REP_M3C
#define REP_M3C 1
#endif
#ifndef DRY_PROBE
#define DRY_PROBE 0
#endif
#ifndef REP_PRO
#define REP_PRO 1
#endif
#ifndef REP_NORM1
#define REP_NORM1 1
#endif
#ifndef REP_GIN
#define REP_GIN 1
#endif
#ifndef REP_M1
#define REP_M1 1
#endif
#ifndef REP_M2
#define REP_M2 1
#endif
#ifndef REP_M3
#define REP_M3 1
#endif
#ifndef REP_M4
#define REP_M4 1
#endif
#ifndef REP_GP
#define REP_GP 1
#endif
#ifndef REP_GG
#define REP_GG 1
#endif
#ifndef REP_GO
#define REP_GO 1
#endif
#ifndef REP_NORM2
#define REP_NORM2 1
#endif
#ifndef REP_FF1
#define REP_FF1 1
#endif
#ifndef REP_FF2
#define REP_FF2 1
#endif
#ifndef PH_PRO
#define PH_PRO 1
#endif
#ifndef PH_NORM1
#define PH_NORM1 1
#endif
#ifndef PH_GIN
#define PH_GIN 1
#endif
#ifndef PH_M1
#define PH_M1 1
#endif
#ifndef PH_M2
#define PH_M2 1
#endif
#ifndef PH_M3
#define PH_M3 1
#endif
#ifndef PH_M4
#define PH_M4 1
#endif
#ifndef PH_GP
#define PH_GP 1
#endif
#ifndef PH_GG
#define PH_GG 1
#endif
#ifndef PH_GO
#define PH_GO 1
#endif
#ifndef PH_NORM2
#define PH_NORM2 1
#endif
#ifndef PH_FFN
#define PH_FFN 1
#endif

struct Args { const float* in[N_IN]; float* out; unsigned char* ws; };
__global__ void __launch_bounds__(512, 2) fwd_kernel(Args a) {
    extern __shared__ __attribute__((aligned(16))) unsigned char lds_raw[];
    LAS unsigned char* lds = (LAS unsigned char*)lds_raw;
    int tid = threadIdx.x; const int bid = blockIdx.x, G = gridDim.x, NT = G * 512, NGW = G * 8;
    int lane, wave, gtid, gw;
#define REIDX() do { tid = threadIdx.x; asm volatile("" : "+v"(tid)); lane = tid & 63; wave = __builtin_amdgcn_readfirstlane(tid >> 6); gtid = bid * 512 + tid; gw = bid * 8 + wave; } while (0)
    REIDX();
    unsigned char* ws = (unsigned char*)in_tab()[N_IN + 1]; float* out = (float*)in_tab()[N_IN];
    if (tid < 4) ((LAS unsigned*)(lds + LDS_MISC))[tid] = 0u;
    __syncthreads();
    XcdBarrier bar = xcd_barrier_post((unsigned*)(ws + WS_CTL) + CW_BAR, (volatile LAS unsigned*)(lds + LDS_MISC));
#define GRID_BAR() do { XcdBarrier b2_ = bar; asm volatile("" : "+s"(b2_.x)); xcd_barrier(b2_); } while (0)
    float* MOD = (float*)(ws + WS_MOD);
    bf16_t* H = (bf16_t*)(ws + WS_H); bf16_t* PROJ = (bf16_t*)(ws + WS_PROJ); bf16_t* OB = (bf16_t*)(ws + WS_O); bf16_t* PB = (bf16_t*)(ws + WS_P); bf16_t* MG = (bf16_t*)(ws + WS_MG);
    bf16_t* XC = (bf16_t*)(ws + WS_XC); bf16_t* LA = (bf16_t*)(ws + WS_LA); bf16_t* LB = (bf16_t*)(ws + WS_LB); float* HF = (float*)(ws + WS_HF); bf16_t* YS = (bf16_t*)(ws + WS_YS);
    float* BU = (float*)(ws + WS_BU); bf16_t* HS = (bf16_t*)(ws + WS_HS); float* KV = (float*)(ws + WS_KV); bf16_t* SIN = (bf16_t*)(ws + WS_SIN);
    bf16_t* XB = (bf16_t*)(ws + WS_XB);

#if PH_PRO
    for (int rep = 0; rep < REP_PRO; ++rep) {
    REIDX();
    prologue_weights(in_tab(), ws, lds, gw, NGW, wave, lane);
    prologue_lru_w(in_tab(), ws, gtid, NT);
    __syncthreads();
    prologue_mod(in_tab(), ws, lds, bid, G, tid, wave, lane);
    prologue_ssm(in_tab(), ws, lds, (bid + 128) % G, G, tid);
    }
#endif
    GRID_BAR();

    for (int l = 0; l < DEPTH; ++l) {
        const float* modl = MOD + (size_t)l * 9 * 12288;
#if PH_NORM1
        for (int rep = 0; rep < REP_NORM1; ++rep) {
        REIDX();
        norm_phase(INP(I_XP), INP(I_XS), XB, l == 0, INP(I_NORM1) + l * D, modl, 0, 1, H, gw, NGW, lane);
        }
#endif
        GRID_BAR();
#if PH_GIN
        for (int rep = 0; rep < REP_GIN; ++rep) {
        REIDX();
        { pg8::Gemm g{H, (const bf16_t*)(ws + WS_WIN1) + (size_t)l * NPROJ * D, MTOK, NPROJ, D, D, D, 0, 0, 0}; pg8::StaticOrder S; S.init(MTOK, NPROJ, G, bid);
          EpiStore E{PROJ, NPROJ, 0, (DRY_PROBE && rep < REP_GIN - 1) ? 1 : 0}; pg8::gemm_phase<EpiStore>(lds, g, S, E); }
        }
#endif
        GRID_BAR();
#if PH_M1
        REIDX();
        m1_attn_prep(PROJ, INP(I_QN) + l * 128, INP(I_KN) + l * 128, out, l, gtid, NT);
        for (int rep = 0; rep < REP_M1; ++rep) {
        REIDX();
        for (int r_ = 0; r_ < REP_M1A; ++r_) { m1_lru_conv(PROJ, XC, INP(I_LCW) + l * 4 * 512, INP(I_LCB) + l * 512, gtid, NT); }
        for (int r_ = 0; r_ < REP_M1B; ++r_) { for (int u = bid; u < 256; u += G) m1_ssm_bu(PROJ, (const bf16_t*)(ws + WS_SSMB) + (size_t)l * 32 * 65536, BU, u, wave, lane); }
        for (int r_ = 0; r_ < REP_M1C; ++r_) { for (int u = bid; u < NCHUNK128 * 4; u += G) m1_ret_kv(PROJ, KV, INP(I_RDEC) + l * 8, lds, u, tid, wave, lane); }
        }
#endif
        GRID_BAR();
#if PH_M2
        for (int rep = 0; rep < REP_M2; ++rep) {
        REIDX();
        for (int r_ = 0; r_ < REP_M2A; ++r_) { pg8::Gemm g{XC, (const bf16_t*)(ws + WS_WLRU) + (size_t)l * 2048 * 128, MTOK, 2048, 128, 512, 128, 0, 3, 128}; pg8::StaticOrder S; S.init(MTOK, 2048, G, bid);
          EpiLru E{XC, LA, LB, INP(I_LBA) + l * 1024, INP(I_LBX) + l * 1024, (const float*)(ws + WS_SPV) + l * 1024}; pg8::gemm_phase<EpiLru>(lds, g, S, E); }
        for (int r_ = 0; r_ < REP_M2B; ++r_) { for (int u = bid; u < 768; u += G) m2_attn_unit(PROJ, INP(I_CK), INP(I_CV), OB, INP(I_SINK) + l * 4, lds, u, l, tid, wave, lane); }
        for (int r_ = 0; r_ < REP_M2C; ++r_) { for (int it = bid; it < 320; it += G) m2_ssm_scan(BU, HS, (const float*)(ws + WS_A16) + (size_t)l * 2 * 32 * 64 * 2, INP(I_SSRE), INP(I_SSIM), out, l, it, tid); }
        for (int r_ = 0; r_ < REP_M2D; ++r_) { m2_ret_scan(KV, SIN, INP(I_SRET), INP(I_RDEC) + l * 8, out, l, gtid, NT); }
        }
#endif
        GRID_BAR();
#if PH_M3
        for (int rep = 0; rep < REP_M3; ++rep) {
        REIDX();
        for (int r_ = 0; r_ < REP_M3A; ++r_) { for (int t = bid; t < 1280; t += G) m3_lru_scan(LA, LB, PROJ, OB, INP(I_SLRU), out, lds, l, t, tid, wave, lane); }
        for (int r_ = 0; r_ < REP_M3B; ++r_) { for (int u = bid; u < 256; u += G) m3_ssm_y(PROJ, (const bf16_t*)(ws + WS_SSMK) + (size_t)l * 32 * 65536, (const bf16_t*)(ws + WS_SSMC) + (size_t)l * 32 * 65536, HS, YS, u, wave, lane); }
        for (int r_ = 0; r_ < REP_M3C; ++r_) { for (int u = bid; u < NCHUNK128 * 4; u += G) m3_ret_out(PROJ, SIN, OB, INP(I_RDEC) + l * 8, INP(I_RGN) + l * 512, lds, u, tid, wave, lane); }
        }
#endif
        GRID_BAR();
#if PH_M4
        for (int rep = 0; rep < REP_M4; ++rep) {
        REIDX();
        { pg8::Gemm g{YS, (const bf16_t*)(ws + WS_WGLU) + (size_t)l * 512 * 512, MTOK, 512, 512, 512, 512, 0, 0, 0}; pg8::StaticOrder S; S.init(MTOK, 512, G, bid);
          EpiGlu E{YS, OB, INP(I_SBGLU) + l * 512}; pg8::gemm_phase<EpiGlu>(lds, g, S, E); }
        }
#endif
        GRID_BAR();
#if PH_GP
        for (int rep = 0; rep < REP_GP; ++rep) {
        REIDX();
        { pg8::Gemm g{OB, (const bf16_t*)(ws + WS_WBR) + (size_t)l * 8192 * 512, MTOK, 8192, 512, D, 512, 3, 0xffff, 512}; pg8::StaticOrder S; S.init(MTOK, 8192, G, bid);
          EpiStore E{PB, 8192, 0, 0}; pg8::gemm_phase<EpiStore>(lds, g, S, E); }
        }
#endif
        GRID_BAR();
#if PH_GG
        for (int rep = 0; rep < REP_GG; ++rep) {
        REIDX();
        { pg8::Gemm g{H, (const bf16_t*)(ws + WS_WGATE) + (size_t)l * 8192 * D, MTOK, 8192, D, D, D, 0, 0, 0}; pg8::StaticOrder S; S.init(MTOK, 8192, G, bid);
          EpiGate E{PB, MG}; pg8::gemm_phase<EpiGate>(lds, g, S, E); }
        }
#endif
        GRID_BAR();
#if PH_GO
        for (int rep = 0; rep < REP_GO; ++rep) {
        REIDX();
        { pg8::Gemm g{MG, (const bf16_t*)(ws + WS_WOUT) + (size_t)l * D * D, MTOK, D, D, D, D, 0, 0, 0}; pg8::StaticOrder S; S.init(MTOK, D, G, bid);
          EpiResid E{XB, XB, nullptr, modl + 2 * 2048, rep < REP_GO - 1 ? 1 : 0}; pg8::gemm_phase<EpiResid>(lds, g, S, E); }
        }
#endif
        GRID_BAR();
#if PH_NORM2
        for (int rep = 0; rep < REP_NORM2; ++rep) {
        REIDX();
        norm_phase(nullptr, nullptr, XB, false, INP(I_NORM2) + l * D, modl, 3, 4, H, gw, NGW, lane);
        }
#endif
        GRID_BAR();
#if PH_FFN
        for (int rep = 0; rep < REP_FF1; ++rep) {
        REIDX();
        { pg8::Gemm g{H, (const bf16_t*)(ws + WS_WFF1) + (size_t)l * DFF * D, MTOK, DFF, D, D, D, 0, 0, 0}; pg8::StaticOrder S; S.init(MTOK, DFF, G, bid);
          EpiStore E{PB, DFF, 1, 0}; pg8::gemm_phase<EpiStore>(lds, g, S, E); }
        }
        GRID_BAR();
        for (int rep = 0; rep < REP_FF2; ++rep) {
        REIDX();
        { pg8::Gemm g{PB, (const bf16_t*)(ws + WS_WFF2) + (size_t)l * D * DFF, MTOK, D, DFF, DFF, DFF, 0, 0, 0}; pg8::StaticOrder S; S.init(MTOK, D, G, bid);
          EpiResid E{XB, XB, l == DEPTH - 1 ? out : nullptr, modl + 5 * 2048, rep < REP_FF2 - 1 ? 1 : 0}; pg8::gemm_phase<EpiResid>(lds, g, S, E); }
        }
        GRID_BAR();
#endif
    }
}

extern "C" void kernel_launch(void* const* d_in, const int* in_sizes, int n_in, void* d_out, int out_size, void* d_ws, size_t ws_size, hipStream_t stream) {
    static int grid = 0;
    if (grid == 0) {
        if (n_in != N_IN || (size_t)out_size != O_END || ws_size < WS_END) { fprintf(stderr, "kernel_launch: unexpected shapes (n_in %d, out %d, ws %zu; need ws >= %zu)\n", n_in, out_size, ws_size, (size_t)WS_END); grid = -1; return; }
        int dev = 0, cus = 0;
        if (hipGetDevice(&dev) != hipSuccess || hipDeviceGetAttribute(&cus, hipDeviceAttributeMultiprocessorCount, dev) != hipSuccess) { grid = -1; return; }
        if (hipFuncSetAttribute((const void*)fwd_kernel, hipFuncAttributeMaxDynamicSharedMemorySize, LDS_BYTES) != hipSuccess) { fprintf(stderr, "kernel_launch: hipFuncSetAttribute failed\n"); grid = -1; return; }
        int per_cu = 0;
        if (hipOccupancyMaxActiveBlocksPerMultiprocessor(&per_cu, (const void*)fwd_kernel, 512, LDS_BYTES) != hipSuccess || per_cu < 1) { fprintf(stderr, "kernel_launch: occupancy query says %d blocks per CU\n", per_cu); grid = -1; (void)hipGetLastError(); return; }
        grid = cus;
    }
    if (grid < 0) return;
    (void)hipMemsetAsync((char*)d_ws + WS_CTL, 0, CTL_ZERO_BYTES, stream);
    Args a{};
    for (int i = 0; i < N_IN; ++i) a.in[i] = (const float*)d_in[i];
    a.out = (float*)d_out; a.ws = (unsigned char*)d_ws;
    hipLaunchKernelGGL(fwd_kernel, dim3(grid), dim3(512), LDS_BYTES, stream, a);
}
```

```cpp
#include <hip/hip_runtime.h>
#include <cstdio>
#include <cstdint>

#define LAS __attribute__((address_space(3)))
typedef unsigned short bf16_t;
typedef short bf16x8 __attribute__((ext_vector_type(8)));
typedef short s16x4 __attribute__((ext_vector_type(4)));
typedef float f32x4 __attribute__((ext_vector_type(4)));
typedef float f32x2 __attribute__((ext_vector_type(2)));
typedef unsigned u32x4 __attribute__((ext_vector_type(4)));
typedef unsigned u32x2 __attribute__((ext_vector_type(2)));

namespace pg8 {
constexpr int BM = 256, BK = 64, HALF = 128, HTB = HALF * BK * 2, STAGE_BYTES = 8 * HTB, NXCD = 8, WGM = 8;
__host__ __device__ __forceinline__ int lds_byte(int r, int c) { const int st = (r >> 4) * 2 + (c >> 5), rr = r & 15, cc = c & 31, ob = rr * 64 + cc * 2; return st * 1024 + (ob ^ (((ob >> 9) & 1) << 5)); }
__host__ __device__ __forceinline__ void stage_rc(int b, int& R, int& C) { const int st = b / 1024, sb = b % 1024, swz = sb ^ (((sb >> 9) & 1) << 5); R = (st >> 1) * 16 + swz / 64; C = (st & 1) * 32 + (swz % 64) / 2; }
__host__ __device__ __forceinline__ int perm32(int rho) { const int n = rho >> 4, i = rho & 15; return 8 * (i >> 2) + 4 * n + (i & 3); }
struct Unit { int pm, pn; };
struct Gemm { const bf16_t* A; const bf16_t* Bt; int M, N, K, lda, ldb, a_shift, a_mask, a_gstride, hot; };
struct StaticOrder {
    int nM, nN, nwg, G, c;
    __host__ __device__ void init(int M, int N, int G_, int c_) { nM = M / BM; nN = N / BM; nwg = nM * nN; G = G_; c = c_; }
    __host__ __device__ bool next(int i, Unit& u) const {
        const long L = (long)i * G + c; if (L >= nwg) return false;
        int wgid = (int)L; { const int q = nwg / NXCD, r = nwg % NXCD, xcd = wgid % NXCD, off = wgid / NXCD; wgid = (xcd < r ? xcd * (q + 1) : r * (q + 1) + (xcd - r) * q) + off; }
        const int nig = WGM * nN, gid = wgid / nig, fm = gid * WGM, gsz = (nM - fm) < WGM ? (nM - fm) : WGM;
        u.pm = fm + ((wgid % nig) % gsz); u.pn = (wgid % nig) / gsz; return true;
    }
};
__device__ __forceinline__ unsigned cvt_pk_bf16(float lo, float hi) { unsigned r; asm volatile("v_cvt_pk_bf16_f32 %0, %1, %2" : "=v"(r) : "v"(lo), "v"(hi)); return r; }

template <class Epi>
__device__ __forceinline__ void gemm_phase(LAS unsigned char* lds, const Gemm g, const StaticOrder& S, const Epi& E) {
    int tid = threadIdx.x; asm volatile("" : "+v"(tid)); const int wid = __builtin_amdgcn_readfirstlane(tid >> 6), lane = tid & 63, wr = wid >> 2, wc = wid & 3, fr = lane & 15, fq = lane >> 4;
    int K_ = g.K; asm volatile("" : "+s"(K_)); const int K = K_, nt = K / BK;
    unsigned voffA[2], voffB[2];
#pragma unroll
    for (int i = 0; i < 2; ++i) { int R, C; stage_rc(tid * 16 + i * 8192, R, C); const int Rb = Epi::PERM ? ((R & ~31) + perm32(R & 31)) : R;
        voffA[i] = (unsigned)(R * g.lda + C) * 2u; voffB[i] = (unsigned)(Rb * g.ldb + C) * 2u; }
    const size_t kstep = (size_t)(BK * 2);
    const size_t hsA = g.hot ? 0 : (size_t)HALF * g.lda * 2, hsB = g.hot ? 0 : (size_t)HALF * g.ldb * 2;
    const unsigned ldsw = (unsigned)wid * 1024u;
    const int aoff = lds_byte(wr * 64 + fr, fq * 8), boff = lds_byte(wc * 32 + fr, fq * 8);
#define PG8_SA(b, h) (((b) * 2 + (h)) * HTB)
#define PG8_SB(b, h) ((4 + (b) * 2 + (h)) * HTB)
#define PG8_STAGE(bufoff, gbase, voff) do { _Pragma("unroll") for (int _i = 0; _i < 2; ++_i) \
        __builtin_amdgcn_global_load_lds((const unsigned*)((const char*)(gbase) + (voff)[_i]), (LAS unsigned*)(lds + (bufoff) + ldsw + _i * 8192), 16, 0, 0); } while (0)
#define PG8_LDA(dst, b, h) do { _Pragma("unroll") for (int m = 0; m < 4; ++m) _Pragma("unroll") for (int k = 0; k < 2; ++k) dst[m][k] = *(const LAS bf16x8*)(lds + PG8_SA(b, h) + aoff + m * 2048 + k * 1024); } while (0)
#define PG8_LDB(dst, b, h) do { _Pragma("unroll") for (int n = 0; n < 2; ++n) _Pragma("unroll") for (int k = 0; k < 2; ++k) dst[n][k] = *(const LAS bf16x8*)(lds + PG8_SB(b, h) + boff + n * 2048 + k * 1024); } while (0)
#define PG8_MMA(ai, bj, At, Bt) do { __builtin_amdgcn_s_setprio(1); _Pragma("unroll") for (int m = 0; m < 4; ++m) _Pragma("unroll") for (int n = 0; n < 2; ++n) _Pragma("unroll") for (int k = 0; k < 2; ++k) \
        acc[ai][bj][m][n] = __builtin_amdgcn_mfma_f32_16x16x32_bf16(Bt[n][k], At[m][k], acc[ai][bj][m][n], 0, 0, 0); __builtin_amdgcn_s_setprio(0); } while (0)
#define PG8_WAIT_V(n) asm volatile("s_waitcnt vmcnt(" #n ")" ::: "memory")
#define PG8_WAIT_L(n) asm volatile("s_waitcnt lgkmcnt(" #n ")" ::: "memory")
#define PG8_BAR __builtin_amdgcn_s_barrier()
#define PG8_SCHED __builtin_amdgcn_sched_barrier(0)
#define PG8_UA(u) ((const char*)g.A + (size_t)(u).pm * 2 * hsA + (size_t)((((u).pn >> g.a_shift) & g.a_mask) * g.a_gstride) * 2)
#define PG8_UB(u) ((const char*)g.Bt + (size_t)(u).pn * 2 * hsB)
    Unit cur, nxt; int ui = 0;
    if (!S.next(0, cur)) return;
    f32x4 acc[2][2][4][2];
#pragma unroll
    for (int a = 0; a < 2; ++a)
#pragma unroll
        for (int b = 0; b < 2; ++b)
#pragma unroll
            for (int m = 0; m < 4; ++m)
#pragma unroll
                for (int n = 0; n < 2; ++n) acc[a][b][m][n] = (f32x4){0.f, 0.f, 0.f, 0.f};
    bf16x8 At[4][2], B0[2][2], B1[2][2];
    const char* cA = PG8_UA(cur); const char* cB = PG8_UB(cur);
    PG8_STAGE(PG8_SB(0, 0), cB, voffB); PG8_STAGE(PG8_SB(0, 1), cB + hsB, voffB); PG8_STAGE(PG8_SA(0, 0), cA, voffA); PG8_STAGE(PG8_SA(0, 1), cA + hsA, voffA);
    if (wr == 1) PG8_BAR;
    PG8_WAIT_V(2); PG8_BAR;
    PG8_STAGE(PG8_SB(1, 0), cB + kstep, voffB); PG8_STAGE(PG8_SA(1, 0), cA + kstep, voffA); PG8_STAGE(PG8_SB(1, 1), cB + hsB + kstep, voffB);
    PG8_WAIT_V(6); PG8_BAR;
    for (;;) {
        const bool has_next = S.next(ui + 1, nxt);
        const char* nA = has_next ? PG8_UA(nxt) : cA; const char* nB = has_next ? PG8_UB(nxt) : cB;
        for (int t = 0; t < nt; t += 2) {
            const bool last = (t == nt - 2);
            const char* a1 = cA + (size_t)(t + 1) * kstep;
            const char* a2 = last ? nA : cA + (size_t)(t + 2) * kstep; const char* b2 = last ? nB : cB + (size_t)(t + 2) * kstep;
            const char* a3 = a2 + kstep; const char* b3 = b2 + kstep;
            PG8_LDB(B0, 0, 0); PG8_LDB(B1, 0, 1); PG8_SCHED; PG8_LDA(At, 0, 0); PG8_STAGE(PG8_SA(1, 1), a1 + hsA, voffA);
            PG8_WAIT_V(8); PG8_WAIT_L(0); PG8_BAR; PG8_MMA(0, 0, At, B0); PG8_MMA(0, 1, At, B1); PG8_BAR; PG8_SCHED;
            PG8_LDA(At, 0, 1); PG8_STAGE(PG8_SB(0, 0), b2, voffB); PG8_STAGE(PG8_SB(0, 1), b2 + hsB, voffB); PG8_STAGE(PG8_SA(0, 0), a2, voffA);
            PG8_WAIT_V(8); PG8_WAIT_L(0); PG8_BAR; PG8_MMA(1, 0, At, B0); PG8_MMA(1, 1, At, B1); PG8_BAR; PG8_SCHED;
            PG8_LDB(B0, 1, 0); PG8_LDB(B1, 1, 1); PG8_SCHED; PG8_LDA(At, 1, 0); PG8_STAGE(PG8_SA(0, 1), a2 + hsA, voffA);
            PG8_WAIT_V(8); PG8_WAIT_L(0); PG8_BAR; PG8_MMA(0, 0, At, B0); PG8_MMA(0, 1, At, B1); PG8_BAR; PG8_SCHED;
            PG8_LDA(At, 1, 1); PG8_STAGE(PG8_SB(1, 0), b3, voffB); PG8_STAGE(PG8_SB(1, 1), b3 + hsB, voffB); PG8_STAGE(PG8_SA(1, 0), a3, voffA);
            PG8_WAIT_V(8); PG8_WAIT_L(0); PG8_BAR; PG8_MMA(1, 0, At, B0); PG8_MMA(1, 1, At, B1); PG8_BAR; PG8_SCHED;
        }
        if (wr == 0) PG8_BAR;
        E(acc, cur, wr, wc, fr, fq);
        if (!has_next) break;
#pragma unroll
        for (int a = 0; a < 2; ++a)
#pragma unroll
            for (int b = 0; b < 2; ++b)
#pragma unroll
                for (int m = 0; m < 4; ++m)
#pragma unroll
                    for (int n = 0; n < 2; ++n) acc[a][b][m][n] = (f32x4){0.f, 0.f, 0.f, 0.f};
        cur = nxt; cA = nA; cB = nB; ++ui;
        if (wr == 1) PG8_BAR;
    }
    PG8_WAIT_V(0);
    PG8_BAR;
#undef PG8_SA
#undef PG8_SB
#undef PG8_STAGE
#undef PG8_LDA
#undef PG8_LDB
#undef PG8_MMA
#undef PG8_WAIT_V
#undef PG8_WAIT_L
#undef PG8_BAR
#undef PG8_SCHED
#undef PG8_UA
#undef PG8_UB
}
}
#define XB_TMO      128
#define XB_XCNT(j)  (256  + 64 * (j))
#define XB_XSUB(j)  (1280 + 64 * (j))
#define XB_XGEN(j)  (2304 + 64 * (j))
#define XB_TOP      3328
#define XB_TOPGEN   3392
#define XCD_BAR_WORDS 3456
#define XB_SPIN_CAP (1u << 18)

__device__ __forceinline__ unsigned xb_ld(unsigned* p)              { return __hip_atomic_load(p, __ATOMIC_RELAXED, __HIP_MEMORY_SCOPE_AGENT); }
__device__ __forceinline__ unsigned xb_add(unsigned* p, unsigned v) { return __hip_atomic_fetch_add(p, v, __ATOMIC_RELAXED, __HIP_MEMORY_SCOPE_AGENT); }
__device__ __forceinline__ unsigned xb_xcc_id() { return (unsigned)__builtin_amdgcn_s_getreg((3 << 11) | 20) & 0xFu; }
#define XB_SPIN(cond, bar) do { unsigned _sp = 0; while (cond) { __builtin_amdgcn_s_sleep(1); \
    if ((++_sp & 255u) == 0u) { if (xb_ld(&(bar)[XB_TMO])) break; if (_sp > XB_SPIN_CAP) { atomicAdd(&(bar)[XB_TMO], 1u); break; } } } } while (0)

struct XcdBarrier {
    unsigned* bar; unsigned x;
    volatile LAS unsigned* st;
};

__device__ __forceinline__ XcdBarrier xcd_barrier_post(unsigned* bar, volatile LAS unsigned* st) {
    XcdBarrier b; b.bar = bar; b.x = xb_xcc_id(); b.st = st;
    if (threadIdx.x == 0) (void)xb_add(&bar[XB_XCNT(b.x)], 1u);
    return b;
}
__device__ __forceinline__ void xcd_barrier_complete(unsigned* bar, unsigned x, unsigned& nloc, unsigned& nx) {
    const unsigned G = gridDim.x * gridDim.y * gridDim.z;
    unsigned sum, cnt, mine, sp = 0u;
    for (;;) {
        sum = 0u; cnt = 0u; mine = 0u;
#pragma unroll
        for (unsigned j = 0; j < 16; ++j) { const unsigned c = xb_ld(&bar[XB_XCNT(j)]); sum += c; cnt += (c > 0u) ? 1u : 0u; mine = (j == x) ? c : mine; }
        if (sum == G) break;
        __builtin_amdgcn_s_sleep(1);
        if ((++sp & 255u) == 0u) { if (xb_ld(&bar[XB_TMO])) break; if (sp > XB_SPIN_CAP) { atomicAdd(&bar[XB_TMO], 1u); break; } }
    }
    nloc = mine > 0u ? mine : 1u; nx = cnt > 0u ? cnt : 1u;
}

__device__ __forceinline__ void xcd_barrier(const XcdBarrier& b) {
    asm volatile("s_waitcnt vmcnt(0)" ::: "memory");
    __syncthreads();
    if (threadIdx.x == 0) {
        unsigned* bar = b.bar;
        __builtin_amdgcn_s_waitcnt(0);
        unsigned nloc = b.st[0], nx = b.st[1];
        if (nloc == 0u) { xcd_barrier_complete(bar, b.x, nloc, nx); b.st[0] = nloc; b.st[1] = nx; }
        const unsigned old = xb_add(&bar[XB_XSUB(b.x)], 1u);
        const unsigned gen = old / nloc;
        if (old + 1u == (gen + 1u) * nloc) {
            __builtin_amdgcn_fence(__ATOMIC_RELEASE, "agent");
            asm volatile("s_waitcnt vmcnt(0)" ::: "memory");
            const unsigned og = xb_add(&bar[XB_TOP], 1u);
            const unsigned tg = og / nx;
            if (og + 1u == (tg + 1u) * nx) xb_add(&bar[XB_TOPGEN], 1u);
            else XB_SPIN(xb_ld(&bar[XB_TOPGEN]) == tg, bar);
            __builtin_amdgcn_fence(__ATOMIC_ACQUIRE, "agent");
            xb_add(&bar[XB_XGEN(b.x)], 1u);
            asm volatile("s_waitcnt vmcnt(0)" ::: "memory");
        } else {
            XB_SPIN(xb_ld(&bar[XB_XGEN(b.x)]) == gen, bar);
            __builtin_amdgcn_fence(__ATOMIC_ACQUIRE, "agent");
            asm volatile("s_waitcnt vmcnt(0)" ::: "memory");
        }
    }
    __syncthreads();
}

constexpr int D = 2048, MCTX = 8192, MLAT = 16384, MTOK = 24576, DEPTH = 4, DFF = 8192;
constexpr int NPROJ = 4608;
constexpr int C_RQ = 0, C_RK = 512, C_RV = 1024, C_RG = 1536, C_LX = 2048, C_LG = 2560, C_AQ = 3072, C_AK = 3584, C_AV = 3840, C_SU = 4096;
constexpr int NCHUNK16 = MTOK / 16;
constexpr int NCHUNK128 = MTOK / 128;
constexpr float EPS = 1e-6f, LOG2E = 1.4426950408889634f;
enum { I_XP = 0, I_XS, I_CK, I_CV, I_SRET, I_SLRU, I_SSRE, I_SSIM, I_C, I_CCTX, I_WMOD, I_BMOD, I_NORM1, I_WIN, I_RDEC, I_RGN, I_LCW, I_LCB, I_LWA, I_LBA, I_LWX, I_LBX, I_LLAM,
       I_QN, I_KN, I_SINK, I_SARE, I_SAIM, I_SLDT, I_SBRE, I_SBIM, I_SCRE, I_SCIM, I_SD, I_SWGLU, I_SBGLU, I_WBR, I_WOUT, I_NORM2, I_WFF1, I_WFF2, N_IN };
constexpr size_t O_YP = 0, O_YS = 16777216, O_NK = 50331648, O_NV = 58720256, O_NRET = 67108864, O_NLRU = 83886080, O_NSRE = 84017152, O_NSIM = 84541440, O_END = 85065728;
constexpr size_t MiB = 1u << 20;
constexpr size_t WS_CTL = 0, CTL_ZERO_BYTES = 1 * MiB;
constexpr size_t WS_MOD = 1 * MiB;
constexpr size_t WS_A16 = 3 * MiB;
constexpr size_t WS_SPV = WS_A16 + 512 * 1024;
constexpr size_t WS_SSMK = 4 * MiB;
constexpr size_t WS_SSMC = 20 * MiB;
constexpr size_t WS_SSMB = 36 * MiB;
constexpr size_t WS_WGLU = 52 * MiB;
constexpr size_t WS_WLRU = 54 * MiB;
constexpr size_t WS_WIN1 = 62 * MiB;
constexpr size_t WS_WGATE = 134 * MiB;
constexpr size_t WS_WBR = 262 * MiB;
constexpr size_t WS_WOUT = 294 * MiB;
constexpr size_t WS_WFF1 = 326 * MiB;
constexpr size_t WS_WFF2 = 454 * MiB;
constexpr size_t WS_H = 582 * MiB;
constexpr size_t WS_PROJ = 678 * MiB;
constexpr size_t WS_O = 894 * MiB;
constexpr size_t WS_P = 990 * MiB;
constexpr size_t WS_MG = 1374 * MiB;
constexpr size_t WS_XB = 1470 * MiB;
constexpr size_t WS_END = 1566 * MiB;
constexpr size_t WS_XC = WS_P;
constexpr size_t WS_LAB = WS_XC + 24 * MiB;
constexpr size_t WS_SU2 = WS_LAB + 120 * MiB;
constexpr size_t WS_HF = WS_SU2 + 24 * MiB;
constexpr size_t WS_YS = WS_HF;
constexpr size_t WS_BU = WS_YS + 24 * MiB;
constexpr size_t WS_HS = WS_BU + 48 * MiB;
constexpr size_t WS_KV = WS_HS + 24 * MiB;
constexpr size_t WS_SIN = WS_KV + 96 * MiB;
static_assert(WS_SIN + 48 * MiB <= WS_XB, "mixer temporaries fit");
constexpr int CW_BAR = 4096;
constexpr int LDS_BYTES = 147456, LDS_MISC = 143360;

typedef const float* fptr_t;
typedef __attribute__((address_space(4))) const fptr_t* tab_t;
__device__ __forceinline__ tab_t in_tab() { tab_t t = (tab_t)__builtin_amdgcn_kernarg_segment_ptr(); asm volatile("" : "+s"(t)); return t; }
#define INP(i) (in_tab()[i])
__device__ __forceinline__ float bf2f(unsigned short b) { return __uint_as_float(((unsigned)b) << 16); }
__device__ __forceinline__ float bflo(unsigned w) { return __uint_as_float(w << 16); }
__device__ __forceinline__ float bfhi(unsigned w) { return __uint_as_float(w & 0xffff0000u); }
__device__ __forceinline__ unsigned pk2(float lo, float hi) { return pg8::cvt_pk_bf16(lo, hi); }
__device__ __forceinline__ bf16x8 pack8(const f32x4 a, const f32x4 b) { u32x4 w; w.x = pk2(a[0], a[1]); w.y = pk2(a[2], a[3]); w.z = pk2(b[0], b[1]); w.w = pk2(b[2], b[3]); return __builtin_bit_cast(bf16x8, w); }
__device__ __forceinline__ float sigmoidf_(float x) { return __builtin_amdgcn_rcpf(1.0f + __builtin_amdgcn_exp2f(-x * LOG2E)); }
__device__ __forceinline__ float siluf_(float x) { return x * sigmoidf_(x); }
__device__ __forceinline__ float gelu_tanh(float x) {
    const float u = 0.7978845608028654f * (x + 0.044715f * x * x * x); return x * sigmoidf_(2.0f * u); }
__device__ __forceinline__ f32x4 mfma16(bf16x8 a, bf16x8 b, f32x4 c) { return __builtin_amdgcn_mfma_f32_16x16x32_bf16(a, b, c, 0, 0, 0); }
__device__ __forceinline__ bf16x8 frag_tr(const LAS unsigned char* img, int ldb, int klo, int khi, int n0, int lane) {
    const int q = (lane & 15) >> 2, p = lane & 3;
    const s16x4 lo = __builtin_amdgcn_ds_read_tr16_b64_v4i16((LAS s16x4*)(img + (klo + q) * ldb + (n0 + 4 * p) * 2));
    const s16x4 hi = __builtin_amdgcn_ds_read_tr16_b64_v4i16((LAS s16x4*)(img + (khi + q) * ldb + (n0 + 4 * p) * 2));
    return __builtin_shufflevector(lo, hi, 0, 1, 2, 3, 4, 5, 6, 7);
}
template <int R> __device__ __forceinline__ void stage_rows(LAS unsigned char* img, int ldl, const bf16_t* src, size_t ldg, int tid) {
#pragma unroll
    for (int c = tid; c < R * 16; c += 512) { const int row = c >> 4, ch = c & 15; *(LAS u32x4*)(img + row * ldl + ch * 16) = *(const u32x4*)(src + (size_t)row * ldg + ch * 8); }
}
__device__ __forceinline__ int mod_row(int pm) { return pm < 32 ? 0 : 1 + ((pm - 32) >> 3); }

struct EpiStore {
    static constexpr bool PERM = true;
    bf16_t* O; int ldc; int relu2; int dry; bf16_t* SU2;
    __device__ __forceinline__ void operator()(const f32x4 (&acc)[2][2][4][2], const pg8::Unit& u, int wr, int wc, int fr, int fq) const {
        const int row0 = u.pm * 256 + wr * 64 + fr, col0 = u.pn * 256 + wc * 32 + 8 * fq;
#pragma unroll
        for (int ai = 0; ai < 2; ++ai)
#pragma unroll
            for (int m = 0; m < 4; ++m) { bf16_t* rowp = O + (size_t)(row0 + ai * 128 + m * 16) * ldc + col0;
#pragma unroll
                for (int bj = 0; bj < 2; ++bj) { f32x4 v0 = acc[ai][bj][m][0], v1 = acc[ai][bj][m][1];
                    if (relu2) {
#pragma unroll
                        for (int j = 0; j < 4; ++j) { const float a = fmaxf(v0[j], 0.f), b = fmaxf(v1[j], 0.f); v0[j] = a * a; v1[j] = b * b; } }
                    u32x4 w; w.x = pk2(v0[0], v0[1]); w.y = pk2(v0[2], v0[3]); w.z = pk2(v1[0], v1[1]); w.w = pk2(v1[2], v1[3]);
                    if (dry) asm volatile("" :: "v"(w));
                    else if (SU2 && col0 >= C_SU) { const int c = col0 + bj * 128 - C_SU; *(u32x4*)(SU2 + ((size_t)(c >> 4) * MTOK + (size_t)(row0 + ai * 128 + m * 16)) * 16 + (c & 8)) = w; }
                    else *(u32x4*)(rowp + bj * 128) = w; } }
    }
};
struct EpiResid {
    static constexpr bool PERM = true;
    const bf16_t* Xi; bf16_t* Xo; float* Xf; const float* gmod; int dry;
    __device__ __forceinline__ void operator()(const f32x4 (&acc)[2][2][4][2], const pg8::Unit& u, int wr, int wc, int fr, int fq) const {
        const int row0 = u.pm * 256 + wr * 64 + fr, col0 = u.pn * 256 + wc * 32 + 8 * fq;
        const float* gp = gmod + (size_t)mod_row(u.pm) * 12288 + col0;
        f32x4 gv[2][2];
#pragma unroll
        for (int bj = 0; bj < 2; ++bj)
#pragma unroll
            for (int n = 0; n < 2; ++n) gv[bj][n] = *(const f32x4*)(gp + bj * 128 + n * 4);
#pragma unroll
        for (int ai = 0; ai < 2; ++ai)
#pragma unroll
            for (int m = 0; m < 4; ++m) { const size_t ro = (size_t)(row0 + ai * 128 + m * 16) * D + col0;
#pragma unroll
                for (int bj = 0; bj < 2; ++bj) { const size_t o = ro + bj * 128;
                    if (dry) { const f32x4 t_ = gv[bj][0] * acc[ai][bj][m][0] + gv[bj][1] * acc[ai][bj][m][1]; asm volatile("" :: "v"(t_)); continue; }
                    const u32x4 xw = *(const u32x4*)(Xi + o);
                    f32x4 v0 = (f32x4){bflo(xw.x), bfhi(xw.x), bflo(xw.y), bfhi(xw.y)} + gv[bj][0] * acc[ai][bj][m][0];
                    f32x4 v1 = (f32x4){bflo(xw.z), bfhi(xw.z), bflo(xw.w), bfhi(xw.w)} + gv[bj][1] * acc[ai][bj][m][1];
                    if (Xf) { *(f32x4*)(Xf + o) = v0; *(f32x4*)(Xf + o + 4) = v1; }
                    else { u32x4 w; w.x = pk2(v0[0], v0[1]); w.y = pk2(v0[2], v0[3]); w.z = pk2(v1[0], v1[1]); w.w = pk2(v1[2], v1[3]); *(u32x4*)(Xo + o) = w; } } }
    }
};
struct EpiGate {
    static constexpr bool PERM = false;
    const bf16_t* P; bf16_t* MG;
    __device__ __forceinline__ void operator()(const f32x4 (&acc)[2][2][4][2], const pg8::Unit& u, int wr, int wc, int fr, int fq) const {
        const int row0 = u.pm * 256 + wr * 64 + fr, ch0 = u.pn * 64 + wc * 16 + 4 * fq;
#pragma unroll
        for (int ai = 0; ai < 2; ++ai)
#pragma unroll
            for (int m = 0; m < 4; ++m) { const size_t row = (size_t)(row0 + ai * 128 + m * 16);
                f32x4 s = (f32x4){0.f, 0.f, 0.f, 0.f};
#pragma unroll
                for (int b = 0; b < 4; ++b) { const u32x2 pw = *(const u32x2*)(P + row * 8192 + b * 2048 + ch0); const f32x4 a = acc[ai][b >> 1][m][b & 1];
                    s[0] += sigmoidf_(a[0]) * bflo(pw.x); s[1] += sigmoidf_(a[1]) * bfhi(pw.x); s[2] += sigmoidf_(a[2]) * bflo(pw.y); s[3] += sigmoidf_(a[3]) * bfhi(pw.y); }
                u32x2 w; w.x = pk2(s[0], s[1]); w.y = pk2(s[2], s[3]); *(u32x2*)(MG + row * D + ch0) = w; }
    }
};
struct EpiLru {
    static constexpr bool PERM = true;
    const bf16_t* XC; bf16_t* LAB; const bf16_t* PROJ; const float* ba; const float* bx; const float* lam;
    __device__ __forceinline__ void operator()(const f32x4 (&acc)[2][2][4][2], const pg8::Unit& u, int wr, int wc, int fr, int fq) const {
        const int row0 = u.pm * 256 + wr * 64 + fr, d = u.pn >> 2;
#pragma unroll
        for (int n = 0; n < 2; ++n) { const int ch0 = (u.pn & 3) * 128 + wc * 32 + 8 * fq + 4 * n;
            const f32x4 bav = *(const f32x4*)(ba + d * 512 + ch0), bxv = *(const f32x4*)(bx + d * 512 + ch0), spv = *(const f32x4*)(lam + d * 512 + ch0);
            bf16_t* rec = LAB + (size_t)(ch0 >> 4) * MTOK * 80 + (ch0 & 15);
#pragma unroll
            for (int ai = 0; ai < 2; ++ai)
#pragma unroll
                for (int m = 0; m < 4; ++m) { const size_t row = (size_t)(row0 + ai * 128 + m * 16);
                    const u32x2 xw = *(const u32x2*)(XC + row * 512 + ch0);
                    const f32x4 xv = (f32x4){bflo(xw.x), bfhi(xw.x), bflo(xw.y), bfhi(xw.y)};
                    f32x4 la, lb;
#pragma unroll
                    for (int e = 0; e < 4; ++e) { const float r = sigmoidf_(acc[ai][0][m][n][e] + bav[e]), ig = sigmoidf_(acc[ai][1][m][n][e] + bxv[e]);
                        const float l2 = r * spv[e], a = __builtin_amdgcn_exp2f(l2); la[e] = l2; lb[e] = sqrtf(fmaxf(1.0f - a * a, 0.f)) * ig * xv[e]; }
                    u32x2 w; w.x = pk2(la[0], la[1]); w.y = pk2(la[2], la[3]); *(u32x2*)(rec + row * 80 + d * 32) = w;
                    w.x = pk2(lb[0], lb[1]); w.y = pk2(lb[2], lb[3]); *(u32x2*)(rec + row * 80 + d * 32 + 16) = w;
                    if (d == 0) *(u32x2*)(rec + row * 80 + 64) = *(const u32x2*)(PROJ + row * NPROJ + C_LG + ch0); } }
    }
};
struct EpiGlu {
    static constexpr bool PERM = true;
    const bf16_t* YS; bf16_t* O; const float* bg;
    __device__ __forceinline__ void operator()(const f32x4 (&acc)[2][2][4][2], const pg8::Unit& u, int wr, int wc, int fr, int fq) const {
        const int row0 = u.pm * 256 + wr * 64 + fr, col0 = u.pn * 256 + wc * 32 + 8 * fq;
#pragma unroll
        for (int ai = 0; ai < 2; ++ai)
#pragma unroll
            for (int m = 0; m < 4; ++m) { const size_t row = (size_t)(row0 + ai * 128 + m * 16);
#pragma unroll
                for (int bj = 0; bj < 2; ++bj) { const int col = col0 + bj * 128;
                    const u32x4 yw = *(const u32x4*)(YS + row * 512 + col);
                    const float yv[8] = {bflo(yw.x), bfhi(yw.x), bflo(yw.y), bfhi(yw.y), bflo(yw.z), bfhi(yw.z), bflo(yw.w), bfhi(yw.w)};
                    float o[8];
#pragma unroll
                    for (int e = 0; e < 8; ++e) o[e] = yv[e] * sigmoidf_(acc[ai][bj][m][e >> 2][e & 3] + bg[col + e]);
                    u32x4 w; w.x = pk2(o[0], o[1]); w.y = pk2(o[2], o[3]); w.z = pk2(o[4], o[5]); w.w = pk2(o[6], o[7]);
                    *(u32x4*)(O + row * D + 1536 + col) = w; } }
    }
};

template <int MODE> __device__ __forceinline__ int src_col(int n_out, int coloff) {
    if (MODE == 0) return coloff + n_out;
    const int pn = n_out >> 8, c = n_out & 255, b = 2 * (c >> 7) + ((c >> 4) & 1), chl = 16 * ((c >> 5) & 3) + (c & 15);
    return coloff + b * 2048 + pn * 64 + chl;
}
template <int MODE> __device__ __forceinline__ void tr_item(const float* W, int ldsrc, int coloff, int K, bf16_t* WT, int row_off, int nblk, LAS float* scr, int item, int lane) {
    const int kb = item / nblk, nb = item % nblk, k0 = 64 * kb, n0 = 32 * nb;
    const int col = src_col<MODE>(n0 + (lane & 31), coloff);
#pragma unroll
    for (int i = 0; i < 32; ++i) { const int kk = 2 * i + (lane >> 5); scr[kk * 33 + (lane & 31)] = W[(size_t)(k0 + kk) * ldsrc + col]; }
    asm volatile("s_waitcnt lgkmcnt(0)" ::: "memory");
    const int c = lane & 7;
#pragma unroll
    for (int j = 0; j < 4; ++j) { const int n = (lane >> 3) + 8 * j; const LAS float* s = scr + (8 * c) * 33 + n;
        u32x4 o; o.x = pk2(s[0 * 33], s[1 * 33]); o.y = pk2(s[2 * 33], s[3 * 33]); o.z = pk2(s[4 * 33], s[5 * 33]); o.w = pk2(s[6 * 33], s[7 * 33]);
        *(u32x4*)(WT + (size_t)(row_off + n0 + n) * K + k0 + 8 * c) = o; }
    asm volatile("s_waitcnt lgkmcnt(0)" ::: "memory");
}
__device__ __forceinline__ void prologue_weights(tab_t in, unsigned char* ws, LAS unsigned char* lds, int gw, int NGW, int wave, int lane) {
    LAS float* scr = (LAS float*)(lds + wave * 16384);
    constexpr int I1 = 32 * 144, I2 = 32 * 256, I3 = 8 * 64, I4 = 32 * 64, I5 = 32 * 256, I6 = 128 * 64, I7 = 8 * 16;
    constexpr int PER = I1 + I2 + 4 * I3 + I4 + I5 + I6 + I7;
    for (int it = gw; it < DEPTH * PER; it += NGW) {
        const int l = it / PER; int r = it % PER;
        if (r < I1) { tr_item<0>(in[I_WIN] + (size_t)l * 2048 * 12800, 12800, 0, 2048, (bf16_t*)(ws + WS_WIN1) + (size_t)l * 4608 * 2048, 0, 144, scr, r, lane); continue; } r -= I1;
        if (r < I2) { tr_item<1>(in[I_WIN] + (size_t)l * 2048 * 12800, 12800, 4608, 2048, (bf16_t*)(ws + WS_WGATE) + (size_t)l * 8192 * 2048, 0, 256, scr, r, lane); continue; } r -= I2;
        if (r < 4 * I3) { const int b = r / I3; tr_item<0>(in[I_WBR] + (size_t)(l * 4 + b) * 512 * 2048, 2048, 0, 512, (bf16_t*)(ws + WS_WBR) + (size_t)l * 8192 * 512, b * 2048, 64, scr, r % I3, lane); continue; } r -= 4 * I3;
        if (r < I4) { tr_item<0>(in[I_WOUT] + (size_t)l * 2048 * 2048, 2048, 0, 2048, (bf16_t*)(ws + WS_WOUT) + (size_t)l * 2048 * 2048, 0, 64, scr, r, lane); continue; } r -= I4;
        if (r < I5) { tr_item<0>(in[I_WFF1] + (size_t)l * 2048 * 8192, 8192, 0, 2048, (bf16_t*)(ws + WS_WFF1) + (size_t)l * 8192 * 2048, 0, 256, scr, r, lane); continue; } r -= I5;
        if (r < I6) { tr_item<0>(in[I_WFF2] + (size_t)l * 8192 * 2048, 2048, 0, 8192, (bf16_t*)(ws + WS_WFF2) + (size_t)l * 2048 * 8192, 0, 64, scr, r, lane); continue; } r -= I6;
        tr_item<0>(in[I_SWGLU] + (size_t)l * 512 * 512, 512, 0, 512, (bf16_t*)(ws + WS_WGLU) + (size_t)l * 512 * 512, 0, 16, scr, r, lane);
    }
}
__device__ __forceinline__ void prologue_lru_w(tab_t in, unsigned char* ws, int gtid, int NT) {
    bf16_t* WL = (bf16_t*)(ws + WS_WLRU);
    for (int idx = gtid; idx < DEPTH * 2048 * 16; idx += NT) {
        const int kc = idx & 15, rr = (idx >> 4) & 2047, l = idx >> 15;
        const int pn = rr >> 8, d = pn >> 2, nb = pn & 3, c = rr & 255, gate = c >> 7, cc = c & 127;
        const float* src = (gate ? in[I_LWX] : in[I_LWA]) + ((size_t)((l * 2 + d) * 4 + nb) * 128 + kc * 8) * 128 + cc;
        u32x4 o; o.x = pk2(src[0], src[128]); o.y = pk2(src[256], src[384]); o.z = pk2(src[512], src[640]); o.w = pk2(src[768], src[896]);
        *(u32x4*)(WL + ((size_t)l * 2048 + rr) * 128 + kc * 8) = o;
    }
    for (int idx = gtid; idx < DEPTH * 1024; idx += NT) ((float*)(ws + WS_SPV))[idx] = -8.0f * LOG2E * log1pf(__expf(-in[I_LLAM][idx]));
}
__device__ __forceinline__ void prologue_mod(tab_t in, unsigned char* ws, LAS unsigned char* lds, int bid, int G, int tid, int wave, int lane) {
    LAS float* sc = (LAS float*)lds;
    LAS float* red = (LAS float*)(lds + 73728);
    for (int i = tid; i < 9 * 2048; i += 512) { const int r = i >> 11, k = i & 2047; const float v = r == 0 ? in[I_CCTX][k] : in[I_C][(r - 1) * 2048 + k]; sc[i] = siluf_(v); }
    __syncthreads();
    float* MOD = (float*)(ws + WS_MOD);
    for (int it = bid; it < DEPTH * 192; it += G) {
        const int l = it / 192, cb = it % 192, col = cb * 64 + lane, kbase = wave * 256;
        const float* w = in[I_WMOD] + ((size_t)l * 2048 + kbase) * 12288 + col;
        float acc[9];
#pragma unroll
        for (int r = 0; r < 9; ++r) acc[r] = 0.f;
#pragma unroll 4
        for (int k = 0; k < 256; k += 4) {
            const float w0 = w[(size_t)k * 12288], w1 = w[(size_t)(k + 1) * 12288], w2 = w[(size_t)(k + 2) * 12288], w3 = w[(size_t)(k + 3) * 12288];
#pragma unroll
            for (int r = 0; r < 9; ++r) { const f32x4 s4 = *(const LAS f32x4*)(sc + r * 2048 + kbase + k); acc[r] += s4[0] * w0 + s4[1] * w1 + s4[2] * w2 + s4[3] * w3; }
        }
#pragma unroll
        for (int r = 0; r < 9; ++r) red[(wave * 9 + r) * 64 + lane] = acc[r];
        __syncthreads();
        for (int i = tid; i < 576; i += 512) { const int r = i >> 6, cl = i & 63; float s = in[I_BMOD][l * 12288 + cb * 64 + cl];
#pragma unroll
            for (int w8 = 0; w8 < 8; ++w8) s += red[(w8 * 9 + r) * 64 + cl];
            MOD[(size_t)(l * 9 + r) * 12288 + cb * 64 + cl] = s; }
        __syncthreads();
    }
}
__device__ __forceinline__ void cpow(float are, float aim, float dt, float tau, float& re, float& im) {
    const float mag = __expf(are * dt * tau); float rev = aim * dt * tau * 0.15915494309189535f; rev -= rintf(rev);
    re = mag * __builtin_amdgcn_cosf(rev); im = mag * __builtin_amdgcn_sinf(rev);
}
__device__ __forceinline__ void prologue_ssm(tab_t in, unsigned char* ws, LAS unsigned char* lds, int bid, int G, int tid) {
    LAS float* pw = (LAS float*)lds;
    LAS float* bb = pw + 2 * 17 * 64 * 2;
    LAS float* cc = bb + 2 * 64 * 16 * 2;
    LAS float* kf = cc + 2 * 16 * 64 * 2;
    LAS float* cf = kf + 2 * 16 * 256;
    for (int un = bid; un < DEPTH * 32; un += G) {
        const int l = un >> 5, g = un & 31;
        __syncthreads();
        if (tid < 128) { const int d = tid >> 6, p = tid & 63; const int ix = ((l * 2 + d) * 32 + g) * 64 + p;
            const float are = in[I_SARE][ix], aim = in[I_SAIM][ix], dt = __expf(in[I_SLDT][(l * 2 + d) * 32 + g]);
            for (int tau = 0; tau <= 16; ++tau) { float re, im; cpow(are, aim, dt, (float)tau, re, im); pw[((d * 17 + tau) * 64 + p) * 2] = re; pw[((d * 17 + tau) * 64 + p) * 2 + 1] = im;
                if (tau == 16) { float* A16 = (float*)(ws + WS_A16); A16[ix * 2] = re; A16[ix * 2 + 1] = im; }
                if (tau == 1) { const float zr = re - 1.0f, zi = im, den = 1.0f / (are * are + aim * aim); cf[(d * 64 + p) * 2] = (zr * are + zi * aim) * den; cf[(d * 64 + p) * 2 + 1] = (zi * are - zr * aim) * den; } }
        }
        __syncthreads();
        for (int i = tid; i < 2048; i += 512) { const int d = i >> 10, p = (i >> 4) & 63, c = i & 15;
            const size_t bix = ((size_t)((l * 2 + d) * 32 + g) * 64 + p) * 16 + c; const float br = in[I_SBRE][bix], bi = in[I_SBIM][bix], fr = cf[(d * 64 + p) * 2], fi = cf[(d * 64 + p) * 2 + 1];
            bb[i * 2] = fr * br - fi * bi; bb[i * 2 + 1] = fr * bi + fi * br;
            const int c2 = (i >> 6) & 15, p2 = i & 63; const size_t cix = ((size_t)((l * 2 + d) * 32 + g) * 16 + c2) * 64 + p2;
            cc[i * 2] = in[I_SCRE][cix]; cc[i * 2 + 1] = in[I_SCIM][cix]; }
        __syncthreads();
        for (int i = tid; i < 8192; i += 512) { const int d = i >> 12, tau = (i >> 8) & 15, c = (i >> 4) & 15, c2 = i & 15; float s = 0.f;
            for (int p = 0; p < 64; ++p) { const float cr = cc[((d * 16 + c) * 64 + p) * 2], ci = cc[((d * 16 + c) * 64 + p) * 2 + 1], ar = pw[((d * 17 + tau) * 64 + p) * 2], ai = pw[((d * 17 + tau) * 64 + p) * 2 + 1];
                const float wr = cr * ar - ci * ai, wi = cr * ai + ci * ar; s += wr * bb[((d * 64 + p) * 16 + c2) * 2] - wi * bb[((d * 64 + p) * 16 + c2) * 2 + 1]; }
            kf[i] = s; }
        __syncthreads();
        bf16_t* KM = (bf16_t*)(ws + WS_SSMK) + (size_t)(l * 32 + g) * 65536;
        bf16_t* CM = (bf16_t*)(ws + WS_SSMC) + (size_t)(l * 32 + g) * 65536;
        bf16_t* BMp = (bf16_t*)(ws + WS_SSMB) + (size_t)(l * 32 + g) * 65536;
        for (int i = tid; i < 32768; i += 512) {
            const int row = i >> 7, col = (i & 127) * 2;
            float v[2], w[2], z[2];
#pragma unroll
            for (int e = 0; e < 2; ++e) { const int cl = col + e;
                { const int t = row >> 4, c = row & 15, s = cl >> 4, c2 = cl & 15; float x = 0.f;
                  if (s <= t) x += kf[(0 * 16 + (t - s)) * 256 + c * 16 + c2];
                  if (s >= t) x += kf[(1 * 16 + (s - t)) * 256 + c * 16 + c2];
                  if (s == t && c == c2) x += in[I_SD][l * 512 + g * 16 + c];
                  v[e] = x; }
                { const int t = row >> 4, c = row & 15, d = cl >> 7, im = (cl >> 6) & 1, p = cl & 63, tau = d == 0 ? t + 1 : 16 - t;
                  const float cr = cc[((d * 16 + c) * 64 + p) * 2], ci = cc[((d * 16 + c) * 64 + p) * 2 + 1], ar = pw[((d * 17 + tau) * 64 + p) * 2], ai = pw[((d * 17 + tau) * 64 + p) * 2 + 1];
                  w[e] = im ? -(cr * ai + ci * ar) : (cr * ar - ci * ai); }
                { const int d = row >> 7, im = (row >> 6) & 1, p = row & 63, s = cl >> 4, c2 = cl & 15, tau = d == 0 ? 15 - s : s;
                  const float ar = pw[((d * 17 + tau) * 64 + p) * 2], ai = pw[((d * 17 + tau) * 64 + p) * 2 + 1], br = bb[((d * 64 + p) * 16 + c2) * 2], bi = bb[((d * 64 + p) * 16 + c2) * 2 + 1];
                  z[e] = im ? (ar * bi + ai * br) : (ar * br - ai * bi); } }
            *(unsigned*)(KM + (size_t)row * 256 + col) = pk2(v[0], v[1]);
            *(unsigned*)(CM + (size_t)row * 256 + col) = pk2(w[0], w[1]);
            *(unsigned*)(BMp + (size_t)row * 256 + col) = pk2(z[0], z[1]);
        }
    }
    __syncthreads();
}
__device__ __forceinline__ void norm_phase(const float* xp, const float* xs, bf16_t* XB, bool first, const float* gain, const float* modl, int sh_idx, int sc_idx, bf16_t* H, int gw, int NGW, int lane) {
    for (int row = gw; row < MTOK; row += NGW) {
        f32x4 v[8]; float ss = 0.f;
        if (first) { const float* src = row < MCTX ? xp + (size_t)row * D : xs + (size_t)(row - MCTX) * D;
#pragma unroll
            for (int j = 0; j < 4; ++j) { v[2 * j] = *(const f32x4*)(src + 8 * (lane + 64 * j)); v[2 * j + 1] = *(const f32x4*)(src + 8 * (lane + 64 * j) + 4); }
#pragma unroll
            for (int j = 0; j < 4; ++j) { u32x4 w; w.x = pk2(v[2 * j][0], v[2 * j][1]); w.y = pk2(v[2 * j][2], v[2 * j][3]); w.z = pk2(v[2 * j + 1][0], v[2 * j + 1][1]); w.w = pk2(v[2 * j + 1][2], v[2 * j + 1][3]);
                *(u32x4*)(XB + (size_t)row * D + 8 * (lane + 64 * j)) = w;
                v[2 * j] = (f32x4){bflo(w.x), bfhi(w.x), bflo(w.y), bfhi(w.y)}; v[2 * j + 1] = (f32x4){bflo(w.z), bfhi(w.z), bflo(w.w), bfhi(w.w)}; } }
        else {
#pragma unroll
            for (int j = 0; j < 4; ++j) { const u32x4 w = *(const u32x4*)(XB + (size_t)row * D + 8 * (lane + 64 * j));
                v[2 * j] = (f32x4){bflo(w.x), bfhi(w.x), bflo(w.y), bfhi(w.y)}; v[2 * j + 1] = (f32x4){bflo(w.z), bfhi(w.z), bflo(w.w), bfhi(w.w)}; } }
#pragma unroll
        for (int j = 0; j < 8; ++j) ss += (v[j][0] * v[j][0] + v[j][1] * v[j][1]) + (v[j][2] * v[j][2] + v[j][3] * v[j][3]);
#pragma unroll
        for (int o = 1; o < 64; o <<= 1) ss += __shfl_xor(ss, o);
        const float rstd = rsqrtf(ss * (1.0f / D) + EPS);
        const int r = row < MCTX ? 0 : 1 + ((row - MCTX) >> 11);
        const float* mp = modl + (size_t)r * 12288;
#pragma unroll
        for (int j = 0; j < 4; ++j) { const int col = 8 * (lane + 64 * j); u32x4 w;
#pragma unroll
            for (int h2 = 0; h2 < 2; ++h2) { const int c4 = col + 4 * h2;
                const f32x4 g4 = *(const f32x4*)(gain + c4), sc4 = *(const f32x4*)(mp + sc_idx * 2048 + c4), sh4 = *(const f32x4*)(mp + sh_idx * 2048 + c4);
                const f32x4 y = v[2 * j + h2] * rstd * g4 * (sc4 + 1.0f) + sh4;
                if (h2 == 0) { w.x = pk2(y[0], y[1]); w.y = pk2(y[2], y[3]); } else { w.z = pk2(y[0], y[1]); w.w = pk2(y[2], y[3]); } }
            *(u32x4*)(H + (size_t)row * D + col) = w; }
    }
}

__device__ __forceinline__ f32x4 up4(const u32x2 w) { return (f32x4){bflo(w.x), bfhi(w.x), bflo(w.y), bfhi(w.y)}; }

__device__ __forceinline__ void m1_attn_prep(bf16_t* PROJ, const float* qn, const float* kn, float* out, int l, int gtid, int NT) {
    for (int idx = gtid; idx < MTOK * 128; idx += NT) {
        const int part = idx & 15, hs = (idx >> 4) & 7, row = idx >> 7; const bool ctx = row < MCTX;
        if (hs >= 6 && !ctx) continue;
        const int col = (hs < 4 ? C_AQ + hs * 128 : hs < 6 ? C_AK + (hs - 4) * 128 : C_AV + (hs - 6) * 128) + part * 8;
        bf16_t* p = PROJ + (size_t)row * NPROJ + col;
        const u32x4 w = *(const u32x4*)p;
        float x[8] = {bflo(w.x), bfhi(w.x), bflo(w.y), bfhi(w.y), bflo(w.z), bfhi(w.z), bflo(w.w), bfhi(w.w)};
        if (hs >= 6) { float* o = out + O_NV + ((size_t)((row >> 8) * 4 + l) * 256 + (row & 255)) * 256 + (hs - 6) * 128 + part * 8;
            *(f32x4*)o = (f32x4){x[0], x[1], x[2], x[3]}; *(f32x4*)(o + 4) = (f32x4){x[4], x[5], x[6], x[7]}; continue; }
        float ss = 0.f;
#pragma unroll
        for (int e = 0; e < 8; ++e) ss += x[e] * x[e];
        ss += __shfl_xor(ss, 1); ss += __shfl_xor(ss, 2); ss += __shfl_xor(ss, 4); ss += __shfl_xor(ss, 8);
        const float rstd = rsqrtf(ss * (1.0f / 128.0f) + EPS);
        const float* gn = (hs < 4 ? qn : kn) + part * 8;
#pragma unroll
        for (int e = 0; e < 8; ++e) x[e] = x[e] * rstd * gn[e];
        if (ctx) { if (hs >= 4) { float* o = out + O_NK + ((size_t)((row >> 8) * 4 + l) * 256 + (row & 255)) * 256 + (hs - 4) * 128 + part * 8;
                *(f32x4*)o = (f32x4){x[0], x[1], x[2], x[3]}; *(f32x4*)(o + 4) = (f32x4){x[4], x[5], x[6], x[7]}; } }
        else { const int t = (row - MCTX) & 2047; const float rp = (float)(t >> 6), cp = (float)(t & 63);
#pragma unroll
            for (int e = 0; e < 8; ++e) { const float other = __shfl_xor(x[e], 8); const int i = (part & 7) * 8 + e; const float pos = i < 32 ? rp : cp;
                float rev = pos * __builtin_amdgcn_exp2f(-(float)(i & 31) * 0.41524101186092029f) * 0.15915494309189535f; rev -= rintf(rev);
                const float cs = __builtin_amdgcn_cosf(rev), sn = __builtin_amdgcn_sinf(rev);
                x[e] = part < 8 ? x[e] * cs - other * sn : x[e] * cs + other * sn; } }
        u32x4 o; o.x = pk2(x[0], x[1]); o.y = pk2(x[2], x[3]); o.z = pk2(x[4], x[5]); o.w = pk2(x[6], x[7]);
        *(u32x4*)p = o;
    }
}
__device__ __forceinline__ void m1_lru_conv(const bf16_t* PROJ, bf16_t* XC, const float* cw, const float* cb, int gtid, int NT) {
    for (int idx = gtid; idx < MTOK * 64; idx += NT) {
        const int row = idx >> 6, c8 = (idx & 63) * 8;
        const int t = row < MCTX ? (row & 255) : ((row - MCTX) & 2047), L = row < MCTX ? 256 : 2048;
        float a[8];
#pragma unroll
        for (int e = 0; e < 8; ++e) a[e] = cb[c8 + e];
#pragma unroll
        for (int j = 0; j < 4; ++j) { const int tt = t - 2 + j;
            if (tt >= 0 && tt < L) { const u32x4 w = *(const u32x4*)(PROJ + (size_t)(row - 2 + j) * NPROJ + C_LX + c8);
                const float x[8] = {bflo(w.x), bfhi(w.x), bflo(w.y), bfhi(w.y), bflo(w.z), bfhi(w.z), bflo(w.w), bfhi(w.w)};
#pragma unroll
                for (int e = 0; e < 8; ++e) a[e] += cw[j * 512 + c8 + e] * x[e]; } }
        u32x4 o; o.x = pk2(a[0], a[1]); o.y = pk2(a[2], a[3]); o.z = pk2(a[4], a[5]); o.w = pk2(a[6], a[7]);
        *(u32x4*)(XC + (size_t)row * 512 + c8) = o;
    }
}
__device__ __forceinline__ void ssm_u_fetch(bf16x8 (&b)[8], const bf16_t* PROJ, int g, int bt, int fr, int G4) {
    const bf16_t* up = PROJ + ((size_t)g * MTOK + (size_t)((bt * 16 + fr) * 16 + (G4 >> 1))) * 16 + 8 * (G4 & 1);
#pragma unroll
    for (int ks = 0; ks < 8; ++ks) b[ks] = *(const bf16x8*)(up + (size_t)(2 * ks) * 16);
}
__device__ __forceinline__ void ssm_bu_batch(const bf16x8 (&af)[2][8], const bf16x8 (&b)[8], float* BU, int g, int bt, int wave, int fr, int G4) {
    f32x4 acc[2] = {(f32x4){0.f, 0.f, 0.f, 0.f}, (f32x4){0.f, 0.f, 0.f, 0.f}};
#pragma unroll
    for (int ks = 0; ks < 8; ++ks) { acc[0] = mfma16(af[0][ks], b[ks], acc[0]); acc[1] = mfma16(af[1][ks], b[ks], acc[1]); }
#pragma unroll
    for (int qi = 0; qi < 2; ++qi) *(f32x4*)(BU + ((size_t)g * NCHUNK16 + bt * 16 + fr) * 256 + (2 * wave + qi) * 16 + 4 * G4) = acc[qi];
}
__device__ __forceinline__ void m1_ssm_bu(const bf16_t* PROJ, const bf16_t* BMl, float* BU, int unit, int wave, int lane) {
    const int g = unit >> 3, bt0 = (unit & 7) * 12, fr = lane & 15, G4 = lane >> 4;
    const bf16_t* BMg = BMl + (size_t)g * 65536;
    bf16x8 af[2][8], b0[8], b1[8];
    ssm_u_fetch(b0, PROJ, g, bt0, fr, G4);
#pragma unroll
    for (int qi = 0; qi < 2; ++qi)
#pragma unroll
        for (int ks = 0; ks < 8; ++ks) af[qi][ks] = *(const bf16x8*)(BMg + (size_t)((2 * wave + qi) * 16 + fr) * 256 + ks * 32 + G4 * 8);
#pragma unroll 1
    for (int bt = bt0; bt < bt0 + 12; bt += 2) {
        ssm_u_fetch(b1, PROJ, g, bt + 1, fr, G4);
        ssm_bu_batch(af, b0, BU, g, bt, wave, fr, G4);
        if (bt + 2 < bt0 + 12) ssm_u_fetch(b0, PROJ, g, bt + 2, fr, G4);
        ssm_bu_batch(af, b1, BU, g, bt + 1, wave, fr, G4);
    }
}
__device__ __forceinline__ float ret_log2gamma(float logit) { return -log1pf(__expf(-logit)) * LOG2E; }
struct RetTileRegs { u32x4 k[4], v[4]; };
__device__ __forceinline__ void ret_tile_fetch(RetTileRegs& R, const bf16_t* PROJ, int unit, int tid) {
    const int cn = unit >> 2, hh = unit & 3; const size_t row0 = (size_t)cn * 128;
#pragma unroll
    for (int i = 0; i < 4; ++i) { const int c = tid + 512 * i, j = c >> 4, ch = c & 15;
        R.k[i] = *(const u32x4*)(PROJ + (row0 + j) * NPROJ + C_RK + hh * 128 + ch * 8); R.v[i] = *(const u32x4*)(PROJ + (row0 + j) * NPROJ + C_RV + hh * 128 + ch * 8); }
}
__device__ __forceinline__ void m1_ret_kv_all(const bf16_t* PROJ, bf16_t* KV, const float* decl, LAS unsigned char* lds, int bid, int G, int tid, int wave, int lane) {
    const int fr = lane & 15, G4 = lane >> 4;
    LAS unsigned char* Ks = lds; LAS unsigned char* Vf = lds + 128 * 288; LAS unsigned char* Vb = lds + 2 * 128 * 288;
    if (bid >= NCHUNK128 * 4) return;
    RetTileRegs R; ret_tile_fetch(R, PROJ, bid, tid);
    for (int unit = bid; unit < NCHUNK128 * 4; unit += G) {
        const int cn = unit >> 2, hh = unit & 3;
        const float lgf = ret_log2gamma(decl[hh]), lgb = ret_log2gamma(decl[4 + hh]);
        __syncthreads();
#pragma unroll
        for (int i = 0; i < 4; ++i) { const int c = tid + 512 * i, j = c >> 4, ch = c & 15; const u32x4 w = R.v[i];
            *(LAS u32x4*)(Ks + j * 288 + ch * 16) = R.k[i];
            const float wf = __builtin_amdgcn_exp2f((float)(127 - j) * lgf), wb = __builtin_amdgcn_exp2f((float)j * lgb);
            const float x[8] = {bflo(w.x), bfhi(w.x), bflo(w.y), bfhi(w.y), bflo(w.z), bfhi(w.z), bflo(w.w), bfhi(w.w)};
            u32x4 o; o.x = pk2(x[0] * wf, x[1] * wf); o.y = pk2(x[2] * wf, x[3] * wf); o.z = pk2(x[4] * wf, x[5] * wf); o.w = pk2(x[6] * wf, x[7] * wf);
            *(LAS u32x4*)(Vf + j * 288 + ch * 16) = o;
            o.x = pk2(x[0] * wb, x[1] * wb); o.y = pk2(x[2] * wb, x[3] * wb); o.z = pk2(x[4] * wb, x[5] * wb); o.w = pk2(x[6] * wb, x[7] * wb);
            *(LAS u32x4*)(Vb + j * 288 + ch * 16) = o; }
        __syncthreads();
        if (unit + G < NCHUNK128 * 4) ret_tile_fetch(R, PROJ, unit + G, tid);
        f32x4 af[8], ab[8];
#pragma unroll
        for (int nt = 0; nt < 8; ++nt) { af[nt] = (f32x4){0.f, 0.f, 0.f, 0.f}; ab[nt] = (f32x4){0.f, 0.f, 0.f, 0.f}; }
#pragma unroll
        for (int ks = 0; ks < 4; ++ks) {
            const bf16x8 a = frag_tr(Ks, 288, 32 * ks + 8 * G4, 32 * ks + 8 * G4 + 4, 16 * wave, lane);
#pragma unroll
            for (int nt = 0; nt < 8; ++nt) { const bf16x8 bf = frag_tr(Vf, 288, 32 * ks + 8 * G4, 32 * ks + 8 * G4 + 4, 16 * nt, lane), bb = frag_tr(Vb, 288, 32 * ks + 8 * G4, 32 * ks + 8 * G4 + 4, 16 * nt, lane);
                af[nt] = mfma16(a, bf, af[nt]); ab[nt] = mfma16(a, bb, ab[nt]); }
        }
        bf16_t* base = KV + (size_t)((cn * 4 + hh) * 2) * 16384;
#pragma unroll
        for (int nt = 0; nt < 8; ++nt) { u32x2 w; w.x = pk2(af[nt][0], af[nt][1]); w.y = pk2(af[nt][2], af[nt][3]); *(u32x2*)(base + (size_t)(16 * nt + fr) * 128 + 16 * wave + 4 * G4) = w;
            w.x = pk2(ab[nt][0], ab[nt][1]); w.y = pk2(ab[nt][2], ab[nt][3]); *(u32x2*)(base + 16384 + (size_t)(16 * nt + fr) * 128 + 16 * wave + 4 * G4) = w; }
    }
}

struct AttnTileRegs { u32x4 kb[2], vb[2]; f32x4 kf[4], vf[4]; };
__device__ __forceinline__ void attn_tile_fetch(AttnTileRegs& R, const bf16_t* PROJ, const float* ck, const float* cv, bool lat, int s, int nb, int tb_lo, size_t rbase, int kvh, int seq, int l, int tid) {
    if (s < nb) { const size_t krow0 = rbase + 64 * (size_t)(tb_lo + s);
#pragma unroll
        for (int i = 0; i < 2; ++i) { const int c = tid + 512 * i, j = c >> 4, ch = c & 15;
            R.kb[i] = *(const u32x4*)(PROJ + (krow0 + j) * NPROJ + C_AK + kvh * 128 + ch * 8); R.vb[i] = *(const u32x4*)(PROJ + (krow0 + j) * NPROJ + C_AV + kvh * 128 + ch * 8); } }
    else { const int p0 = 64 * (s - nb);
#pragma unroll
        for (int i = 0; i < 2; ++i) { const int c = tid + 512 * i, j = c >> 4, ch = c & 15; const size_t off = ((size_t)((seq * 4 + l) * 256 + p0 + j)) * 256 + kvh * 128 + ch * 8;
            R.kf[2 * i] = *(const f32x4*)(ck + off); R.kf[2 * i + 1] = *(const f32x4*)(ck + off + 4); R.vf[2 * i] = *(const f32x4*)(cv + off); R.vf[2 * i + 1] = *(const f32x4*)(cv + off + 4); } }
}
__device__ __forceinline__ void attn_tile_commit(const AttnTileRegs& R, LAS unsigned char* Ks, LAS unsigned char* Vs, int s, int nb, int tid) {
#pragma unroll
    for (int i = 0; i < 2; ++i) { const int c = tid + 512 * i, j = c >> 4, ch = c & 15;
        if (s < nb) { *(LAS u32x4*)(Ks + j * 272 + ch * 16) = R.kb[i]; *(LAS u32x4*)(Vs + j * 288 + ch * 16) = R.vb[i]; }
        else { u32x4 o; o.x = pk2(R.kf[2 * i][0], R.kf[2 * i][1]); o.y = pk2(R.kf[2 * i][2], R.kf[2 * i][3]); o.z = pk2(R.kf[2 * i + 1][0], R.kf[2 * i + 1][1]); o.w = pk2(R.kf[2 * i + 1][2], R.kf[2 * i + 1][3]); *(LAS u32x4*)(Ks + j * 272 + ch * 16) = o;
            o.x = pk2(R.vf[2 * i][0], R.vf[2 * i][1]); o.y = pk2(R.vf[2 * i][2], R.vf[2 * i][3]); o.z = pk2(R.vf[2 * i + 1][0], R.vf[2 * i + 1][1]); o.w = pk2(R.vf[2 * i + 1][2], R.vf[2 * i + 1][3]); *(LAS u32x4*)(Vs + j * 288 + ch * 16) = o; } }
}
__device__ __forceinline__ void m2_attn_unit(const bf16_t* PROJ, const float* ck, const float* cv, bf16_t* O, const float* sink, LAS unsigned char* lds, int u, int l, int tid, int wave, int lane) {
    const int fr = lane & 15, G4 = lane >> 4;
    const bool lat = u >= 256; int seq, kvh, qb; size_t rbase;
    if (!lat) { seq = u >> 3; kvh = (u >> 2) & 1; qb = u & 3; rbase = (size_t)seq * 256; }
    else { const int v = u - 256; seq = v >> 6; kvh = (v >> 5) & 1; qb = v & 31; rbase = (size_t)MCTX + (size_t)seq * 2048; }
    const int head = 2 * kvh + (wave >> 2), qq = (wave & 3) * 16 + fr;
    const int tb_lo = lat ? (qb - 2 < 0 ? 0 : qb - 2) : 0, tb_hi = lat ? (qb + 2 > 31 ? 31 : qb + 2) : 3, nb = tb_hi - tb_lo + 1, ntile = lat ? nb + 4 : nb;
    LAS unsigned char* Ks = lds; LAS unsigned char* Vs = lds + 64 * 272;
    AttnTileRegs R;
    attn_tile_fetch(R, PROJ, ck, cv, lat, 0, nb, tb_lo, rbase, kvh, seq, l, tid);
    bf16x8 qf[4];
    { const bf16_t* qp = PROJ + (rbase + qb * 64 + qq) * NPROJ + C_AQ + head * 128 + G4 * 8;
#pragma unroll
      for (int ks = 0; ks < 4; ++ks) qf[ks] = *(const bf16x8*)(qp + ks * 32); }
    float mrun = sink[head] * LOG2E, lsum = G4 == 0 ? 1.0f : 0.0f;
    f32x4 oacc[8];
#pragma unroll
    for (int mt = 0; mt < 8; ++mt) oacc[mt] = (f32x4){0.f, 0.f, 0.f, 0.f};
    const float SC2 = 0.08838834764831845f * LOG2E;
    for (int s = 0; s < ntile; ++s) {
        int mask = 0;
        if (lat && s < nb) { const int tb = tb_lo + s; mask = tb == qb - 2 ? 1 : tb == qb + 2 ? 2 : 0; }
        __syncthreads();
        attn_tile_commit(R, Ks, Vs, s, nb, tid);
        __syncthreads();
        if (s + 1 < ntile) attn_tile_fetch(R, PROJ, ck, cv, lat, s + 1, nb, tb_lo, rbase, kvh, seq, l, tid);
        f32x4 sa[4];
#pragma unroll
        for (int nt = 0; nt < 4; ++nt) { sa[nt] = (f32x4){0.f, 0.f, 0.f, 0.f};
#pragma unroll
            for (int ks = 0; ks < 4; ++ks) sa[nt] = mfma16(*(const LAS bf16x8*)(Ks + (nt * 16 + fr) * 272 + (ks * 32 + G4 * 8) * 2), qf[ks], sa[nt]); }
        float tmax = -3.0e38f;
#pragma unroll
        for (int nt = 0; nt < 4; ++nt)
#pragma unroll
            for (int r = 0; r < 4; ++r) { const int jj = 16 * nt + 4 * G4 + r; float sv = sa[nt][r] * SC2;
                if (mask == 1 && jj < qq) sv = -3.0e38f; if (mask == 2 && jj > qq) sv = -3.0e38f; sa[nt][r] = sv; tmax = fmaxf(tmax, sv); }
        tmax = fmaxf(tmax, __shfl_xor(tmax, 16)); tmax = fmaxf(tmax, __shfl_xor(tmax, 32));
        const float mnew = fmaxf(mrun, tmax), alpha = __builtin_amdgcn_exp2f(mrun - mnew); mrun = mnew;
        float ps = 0.f;
#pragma unroll
        for (int nt = 0; nt < 4; ++nt)
#pragma unroll
            for (int r = 0; r < 4; ++r) { const float p = __builtin_amdgcn_exp2f(sa[nt][r] - mnew); sa[nt][r] = p; ps += p; }
        lsum = lsum * alpha + ps;
        const bf16x8 pf0 = pack8(sa[0], sa[1]), pf1 = pack8(sa[2], sa[3]);
#pragma unroll
        for (int mt = 0; mt < 8; ++mt) { oacc[mt] = oacc[mt] * alpha;
            oacc[mt] = mfma16(frag_tr(Vs, 288, 4 * G4, 16 + 4 * G4, 16 * mt, lane), pf0, oacc[mt]);
            oacc[mt] = mfma16(frag_tr(Vs, 288, 32 + 4 * G4, 48 + 4 * G4, 16 * mt, lane), pf1, oacc[mt]); }
    }
    lsum += __shfl_xor(lsum, 16); lsum += __shfl_xor(lsum, 32);
    const float inv = 1.0f / lsum;
    bf16_t* op = O + (rbase + qb * 64 + qq) * D + 1024 + head * 128 + 4 * G4;
#pragma unroll
    for (int mt = 0; mt < 8; ++mt) { u32x2 w; w.x = pk2(oacc[mt][0] * inv, oacc[mt][1] * inv); w.y = pk2(oacc[mt][2] * inv, oacc[mt][3] * inv); *(u32x2*)(op + 16 * mt) = w; }
}
__device__ __forceinline__ void m2_ssm_scan(const float* BU, bf16_t* HS, const float* A16l, const float* sre, const float* sim, float* out, int l, int item, int tid) {
    const int seq = item >> 3, g = (item & 7) * 4 + (tid >> 7), c = tid & 127, dir = c >> 6, p = c & 63;
    const bool lat = seq >= 32; const int chunk0 = lat ? 512 + (seq - 32) * 128 : seq * 16, N = lat ? 128 : 16;
    const float ar = A16l[((dir * 32 + g) * 64 + p) * 2], ai = A16l[((dir * 32 + g) * 64 + p) * 2 + 1];
    float hr = 0.f, hi = 0.f;
    if (lat) { const size_t ix = ((size_t)(((seq - 32) * 4 + l) * 2 + dir) * 32 + g) * 64 + p; hr = sre[ix]; hi = sim[ix]; }
    const long step = dir == 0 ? 1 : -1; const int cfirst = chunk0 + (dir == 0 ? 0 : N - 1);
    const float* bp = BU + ((size_t)g * NCHUNK16 + cfirst) * 256 + dir * 128 + p;
    bf16_t* hp = HS + ((size_t)cfirst * 32 + g) * 256 + dir * 128 + p;
    for (int s0 = 0; s0 < N; s0 += 16) {
        float br[16], bi[16];
#pragma unroll
        for (int k = 0; k < 16; ++k) { br[k] = bp[(long)(s0 + k) * step * 256]; bi[k] = bp[(long)(s0 + k) * step * 256 + 64]; }
#pragma unroll
        for (int k = 0; k < 16; ++k) { bf16_t* h2 = hp + (long)(s0 + k) * step * 8192; h2[0] = (bf16_t)(pk2(hr, 0.f) & 0xffffu); h2[64] = (bf16_t)(pk2(hi, 0.f) & 0xffffu);
            const float nr = ar * hr - ai * hi + br[k], ni = ar * hi + ai * hr + bi[k]; hr = nr; hi = ni; }
    }
    if (!lat) { const size_t ix = ((size_t)((seq * 4 + l) * 2 + dir) * 32 + g) * 64 + p; out[O_NSRE + ix] = hr; out[O_NSIM + ix] = hi; }
}
template <int N> __device__ __forceinline__ f32x4 ret_scan_run(const bf16_t* KV, bf16_t* SIN, f32x4 S, float g128, int c0, int dir, size_t inner) {
    u32x2 kv[N];
#pragma unroll
    for (int st = 0; st < N; ++st) { const int cn = c0 + (dir == 0 ? st : N - 1 - st); kv[st] = *(const u32x2*)(KV + (size_t)cn * 131072 + inner); }
#pragma unroll
    for (int st = 0; st < N; ++st) { const int cn = c0 + (dir == 0 ? st : N - 1 - st); u32x2 w; w.x = pk2(S[0], S[1]); w.y = pk2(S[2], S[3]); *(u32x2*)(SIN + (size_t)cn * 131072 + inner) = w; S = S * g128 + up4(kv[st]); }
    return S;
}
__device__ __forceinline__ void m2_ret_scan(const bf16_t* KV, bf16_t* SIN, const float* sret, const float* decl, float* out, int l, int gtid, int NT) {
    for (int idx = gtid; idx < 40 * 4 * 2 * 128 * 32; idx += NT) {
        const int dk4 = (idx & 31) * 4, dv = (idx >> 5) & 127, dir = (idx >> 12) & 1, hh = (idx >> 13) & 3, seq = idx >> 15;
        const bool lat = seq >= 32; const int c0 = lat ? 64 + (seq - 32) * 16 : seq * 2;
        const float g128 = __builtin_amdgcn_exp2f(128.0f * ret_log2gamma(decl[dir * 4 + hh]));
        const size_t inner = (size_t)(hh * 2 + dir) * 16384 + (size_t)dv * 128 + dk4;
        f32x4 S = (f32x4){0.f, 0.f, 0.f, 0.f};
        if (lat) { const float* sp = sret + ((size_t)((((seq - 32) * 4 + l) * 2 + dir) * 4 + hh) * 128 + dk4) * 128 + dv; S = (f32x4){sp[0], sp[128], sp[256], sp[384]};
            S = ret_scan_run<16>(KV, SIN, S, g128, c0, dir, inner); }
        else { S = ret_scan_run<2>(KV, SIN, S, g128, c0, dir, inner);
            float* op = out + O_NRET + ((size_t)(((seq * 4 + l) * 2 + dir) * 4 + hh) * 128 + dk4) * 128 + dv; op[0] = S[0]; op[128] = S[1]; op[256] = S[2]; op[384] = S[3]; }
    }
}

__device__ __forceinline__ f32x4 ex4(const f32x4 v) { return (f32x4){__builtin_amdgcn_exp2f(v[0]), __builtin_amdgcn_exp2f(v[1]), __builtin_amdgcn_exp2f(v[2]), __builtin_amdgcn_exp2f(v[3])}; }
template <int T, int LPS> __device__ __forceinline__ void lru_task(const bf16_t* LAB, bf16_t* O, const float* slru, float* out, LAS unsigned char* lds, int l, bool lat, int seq, int cg, size_t rbase, int tid) {
    constexpr int CH = 4 * LPS, SEGS = 512 / LPS;
    const int chq = tid & (LPS - 1), seg = tid / LPS, ch0 = cg * CH + chq * 4;
    LAS f32x4* sA = (LAS f32x4*)lds;
    LAS f32x4* sH = sA + 1024;
    const bf16_t* rec = LAB + ((size_t)(ch0 >> 4) * MTOK + rbase + (size_t)seg * T) * 80 + (ch0 & 15);
    f32x4 As = (f32x4){0.f, 0.f, 0.f, 0.f}, hf = As, Ab = As, hb = As;
    {   u32x2 af[T], bf_[T], ab[T], bb[T];
        const bf16_t* q = rec;
#pragma unroll
        for (int k = 0; k < T; ++k) { af[k] = *(const u32x2*)q; bf_[k] = *(const u32x2*)(q + 16); ab[k] = *(const u32x2*)(q + 32); bb[k] = *(const u32x2*)(q + 48); q += 80; }
#pragma unroll
        for (int k = 0; k < T; ++k) { const f32x4 la = up4(af[k]); hf = ex4(la) * hf + up4(bf_[k]); As += la;
            const f32x4 lc = up4(ab[T - 1 - k]); hb = ex4(lc) * hb + up4(bb[T - 1 - k]); Ab += lc; } }
    __syncthreads();
    sA[seg * LPS + chq] = As; sH[seg * LPS + chq] = hf; sA[512 + seg * LPS + chq] = Ab; sH[512 + seg * LPS + chq] = hb;
    __syncthreads();
    f32x4 hinf = (f32x4){0.f, 0.f, 0.f, 0.f}, hinb = hinf;
    if (lat) { hinf = *(const f32x4*)(slru + (size_t)(((seq - 32) * 4 + l) * 2 + 0) * 512 + ch0); hinb = *(const f32x4*)(slru + (size_t)(((seq - 32) * 4 + l) * 2 + 1) * 512 + ch0); }
    for (int s = 0; s < seg; ++s) hinf = ex4(sA[s * LPS + chq]) * hinf + sH[s * LPS + chq];
    for (int s = SEGS - 1; s > seg; --s) hinb = ex4(sA[512 + s * LPS + chq]) * hinb + sH[512 + s * LPS + chq];
    f32x4 hfv[T]; f32x4 h = hinf;
    {   u32x2 af[T], bf_[T];
        const bf16_t* q = rec;
#pragma unroll
        for (int k = 0; k < T; ++k) { af[k] = *(const u32x2*)q; bf_[k] = *(const u32x2*)(q + 16); q += 80; }
#pragma unroll
        for (int k = 0; k < T; ++k) { h = ex4(up4(af[k])) * h + up4(bf_[k]); hfv[k] = h; } }
    if (!lat && seg == SEGS - 1) *(f32x4*)(out + O_NLRU + (size_t)((seq * 4 + l) * 2 + 0) * 512 + ch0) = h;
    h = hinb;
    {   u32x2 ab[T], bb[T], rg[T];
        const bf16_t* q = rec;
#pragma unroll
        for (int k = 0; k < T; ++k) { ab[k] = *(const u32x2*)(q + 32); bb[k] = *(const u32x2*)(q + 48); rg[k] = *(const u32x2*)(q + 64); q += 80; }
        bf16_t* qo = O + (rbase + (size_t)seg * T + (T - 1)) * D + 512 + ch0;
#pragma unroll
        for (int k = T - 1; k >= 0; --k) { h = ex4(up4(ab[k])) * h + up4(bb[k]); const f32x4 g = up4(rg[k]); const f32x4 sm = hfv[k] + h;
            u32x2 w; w.x = pk2(gelu_tanh(g[0]) * sm[0], gelu_tanh(g[1]) * sm[1]); w.y = pk2(gelu_tanh(g[2]) * sm[2], gelu_tanh(g[3]) * sm[3]); *(u32x2*)qo = w; qo -= D; asm volatile("" : "+v"(qo)); } }
    if (!lat && seg == 0) *(f32x4*)(out + O_NLRU + (size_t)((seq * 4 + l) * 2 + 1) * 512 + ch0) = h;
}
__device__ __forceinline__ void m3_lru_scan(const bf16_t* LAB, bf16_t* O, const float* slru, float* out, LAS unsigned char* lds, int l, int task, int tid) {
    if (task < 256) { const int seq = 32 + (task >> 5); lru_task<16, 4>(LAB, O, slru, out, lds, l, true, seq, task & 31, (size_t)MCTX + (size_t)(seq - 32) * 2048, tid); }
    else { const int t2 = task - 256, seq = t2 >> 3; lru_task<8, 16>(LAB, O, slru, out, lds, l, false, seq, t2 & 7, (size_t)seq * 256, tid); }
}
__device__ __forceinline__ void m3_ssm_y(const bf16_t* PROJ, const bf16_t* KMl, const bf16_t* CMl, const bf16_t* HS, bf16_t* YS, int unit, int wave, int lane) {
    const int g = unit >> 3, bt0 = (unit & 7) * 12, fr = lane & 15, G4 = lane >> 4;
    const bf16_t* KMg = KMl + (size_t)g * 65536; const bf16_t* CMg = CMl + (size_t)g * 65536;
    bf16x8 kf[2][8], cf[2][8];
#pragma unroll
    for (int qi = 0; qi < 2; ++qi)
#pragma unroll
        for (int ks = 0; ks < 8; ++ks) { kf[qi][ks] = *(const bf16x8*)(KMg + (size_t)((2 * wave + qi) * 16 + fr) * 256 + ks * 32 + G4 * 8); cf[qi][ks] = *(const bf16x8*)(CMg + (size_t)((2 * wave + qi) * 16 + fr) * 256 + ks * 32 + G4 * 8); }
    for (int bt = bt0; bt < bt0 + 12; ++bt) {
        const int chunk = bt * 16 + fr;
        const bf16_t* up = PROJ + ((size_t)g * MTOK + (size_t)(chunk * 16 + (G4 >> 1))) * 16 + 8 * (G4 & 1);
        const bf16_t* hp = HS + ((size_t)chunk * 32 + g) * 256 + G4 * 8;
        f32x4 acc[2] = {(f32x4){0.f, 0.f, 0.f, 0.f}, (f32x4){0.f, 0.f, 0.f, 0.f}};
#pragma unroll
        for (int ks = 0; ks < 8; ++ks) { const bf16x8 bu = *(const bf16x8*)(up + (size_t)(2 * ks) * 16), bh = *(const bf16x8*)(hp + ks * 32);
            acc[0] = mfma16(kf[0][ks], bu, acc[0]); acc[1] = mfma16(kf[1][ks], bu, acc[1]); acc[0] = mfma16(cf[0][ks], bh, acc[0]); acc[1] = mfma16(cf[1][ks], bh, acc[1]); }
#pragma unroll
        for (int qi = 0; qi < 2; ++qi) { const int t = 2 * wave + qi; u32x2 w; w.x = pk2(gelu_tanh(acc[qi][0]), gelu_tanh(acc[qi][1])); w.y = pk2(gelu_tanh(acc[qi][2]), gelu_tanh(acc[qi][3]));
            *(u32x2*)(YS + (size_t)(chunk * 16 + t) * 512 + g * 16 + 4 * G4) = w; }
    }
}
__device__ __forceinline__ void m3_ret_out_all(const bf16_t* PROJ, const bf16_t* SIN, bf16_t* O, const float* decl, const float* gnl, LAS unsigned char* lds, int bid, int G, int tid, int wave, int lane) {
    const int fr = lane & 15, G4 = lane >> 4;
    LAS unsigned char* Ks = lds; LAS unsigned char* Vs = lds + 128 * 272;
    if (bid >= NCHUNK128 * 4) return;
    RetTileRegs R; ret_tile_fetch(R, PROJ, bid, tid);
    for (int unit = bid; unit < NCHUNK128 * 4; unit += G) {
    const int cn = unit >> 2, hh = unit & 3;
    const size_t row0 = (size_t)cn * 128;
    const float lgf = ret_log2gamma(decl[hh]), lgb = ret_log2gamma(decl[4 + hh]), scale = 0.08838834764831845f;
    __syncthreads();
#pragma unroll
    for (int i = 0; i < 4; ++i) { const int c = tid + 512 * i, j = c >> 4, ch = c & 15; *(LAS u32x4*)(Ks + j * 272 + ch * 16) = R.k[i]; *(LAS u32x4*)(Vs + j * 288 + ch * 16) = R.v[i]; }
    const int i = wave * 16 + fr;
    bf16x8 qf[4];
    { const bf16_t* qp = PROJ + (row0 + i) * NPROJ + C_RQ + hh * 128 + G4 * 8;
#pragma unroll
      for (int ks = 0; ks < 4; ++ks) qf[ks] = *(const bf16x8*)(qp + ks * 32); }
    __syncthreads();
    if (unit + G < NCHUNK128 * 4) ret_tile_fetch(R, PROJ, unit + G, tid);
    bf16x8 pf[4];
    {   f32x4 sa[8];
#pragma unroll
        for (int jt = 0; jt < 8; ++jt) { sa[jt] = (f32x4){0.f, 0.f, 0.f, 0.f};
#pragma unroll
            for (int ks = 0; ks < 4; ++ks) sa[jt] = mfma16(*(const LAS bf16x8*)(Ks + (jt * 16 + fr) * 272 + (ks * 32 + G4 * 8) * 2), qf[ks], sa[jt]); }
#pragma unroll
        for (int jt = 0; jt < 8; ++jt)
#pragma unroll
            for (int r = 0; r < 4; ++r) { const int dlt = i - (16 * jt + 4 * G4 + r); float f = 0.f;
                if (dlt >= 0) f += __builtin_amdgcn_exp2f((float)dlt * lgf); if (dlt <= 0) f += __builtin_amdgcn_exp2f((float)(-dlt) * lgb); sa[jt][r] *= f * scale; }
#pragma unroll
        for (int s4 = 0; s4 < 4; ++s4) pf[s4] = pack8(sa[2 * s4], sa[2 * s4 + 1]);
    }
    const float wfi = __builtin_amdgcn_exp2f((float)(i + 1) * lgf) * scale, wbi = __builtin_amdgcn_exp2f((float)(128 - i) * lgb) * scale;
    const bf16_t* Sf = SIN + (size_t)((cn * 4 + hh) * 2) * 16384 + (size_t)fr * 128 + G4 * 8; const bf16_t* Sb = Sf + 16384;
    f32x4 o[8]; float sum = 0.f;
#pragma unroll
    for (int mt = 0; mt < 8; ++mt) {
        f32x4 oi = (f32x4){0.f, 0.f, 0.f, 0.f}, of = oi, ob = oi;
#pragma unroll
        for (int s4 = 0; s4 < 4; ++s4) { oi = mfma16(frag_tr(Vs, 288, 32 * s4 + 4 * G4, 32 * s4 + 16 + 4 * G4, 16 * mt, lane), pf[s4], oi);
            of = mfma16(*(const bf16x8*)(Sf + (size_t)mt * 2048 + s4 * 32), qf[s4], of); ob = mfma16(*(const bf16x8*)(Sb + (size_t)mt * 2048 + s4 * 32), qf[s4], ob); }
        o[mt] = oi + of * wfi + ob * wbi; sum += (o[mt][0] + o[mt][1]) + (o[mt][2] + o[mt][3]);
    }
    sum += __shfl_xor(sum, 16); sum += __shfl_xor(sum, 32);
    const float mu = sum * (1.0f / 128.0f); float q = 0.f;
#pragma unroll
    for (int mt = 0; mt < 8; ++mt) { o[mt] = o[mt] - mu; q += (o[mt][0] * o[mt][0] + o[mt][1] * o[mt][1]) + (o[mt][2] * o[mt][2] + o[mt][3] * o[mt][3]); }
    q += __shfl_xor(q, 16); q += __shfl_xor(q, 32);
    const float rstd = rsqrtf(q * (1.0f / 128.0f) + EPS);
#pragma unroll
    for (int mt = 0; mt < 8; ++mt) { const int dv0 = 16 * mt + 4 * G4; const f32x4 gn4 = *(const f32x4*)(gnl + hh * 128 + dv0);
        const u32x2 gw = *(const u32x2*)(PROJ + (row0 + i) * NPROJ + C_RG + hh * 128 + dv0);
        const float g0 = siluf_(bflo(gw.x)), g1 = siluf_(bfhi(gw.x)), g2 = siluf_(bflo(gw.y)), g3 = siluf_(bfhi(gw.y));
        u32x2 w; w.x = pk2(o[mt][0] * rstd * gn4[0] * g0, o[mt][1] * rstd * gn4[1] * g1); w.y = pk2(o[mt][2] * rstd * gn4[2] * g2, o[mt][3] * rstd * gn4[3] * g3);
        *(u32x2*)(O + (row0 + i) * D + hh * 128 + dv0) = w; }
    }
}
#ifndef HOT_PROBE
#define HOT_PROBE 0
#endif
#ifndef REP_M1A
#define REP_M1A 1
#endif
#ifndef REP_M1B
#define REP_M1B 1
#endif
#ifndef REP_M1C
#define REP_M1C 1
#endif
#ifndef REP_M2A
#define REP_M2A 1
#endif
#ifndef REP_M2B
#define REP_M2B 1
#endif
#ifndef REP_M2C
#define REP_M2C 1
#endif
#ifndef REP_M2D
#define REP_M2D 1
#endif
#ifndef REP_M3A
#define REP_M3A 1
#endif
#ifndef REP_M3B
#define REP_M3B 1
#endif
#ifndef REP_M3C
#define REP_M3C 1
#endif
#ifndef DRY_PROBE
#define DRY_PROBE 0
#endif
#ifndef REP_PRO
#define REP_PRO 1
#endif
#ifndef REP_NORM1
#define REP_NORM1 1
#endif
#ifndef REP_GIN
#define REP_GIN 1
#endif
#ifndef REP_M1
#define REP_M1 1
#endif
#ifndef REP_M2
#define REP_M2 1
#endif
#ifndef REP_M3
#define REP_M3 1
#endif
#ifndef REP_M4
#define REP_M4 1
#endif
#ifndef REP_GP
#define REP_GP 1
#endif
#ifndef REP_GG
#define REP_GG 1
#endif
#ifndef REP_GO
#define REP_GO 1
#endif
#ifndef REP_NORM2
#define REP_NORM2 1
#endif
#ifndef REP_FF1
#define REP_FF1 1
#endif
#ifndef REP_FF2
#define REP_FF2 1
#endif
#ifndef PH_PRO
#define PH_PRO 1
#endif
#ifndef PH_NORM1
#define PH_NORM1 1
#endif
#ifndef PH_GIN
#define PH_GIN 1
#endif
#ifndef PH_M1
#define PH_M1 1
#endif
#ifndef PH_M2
#define PH_M2 1
#endif
#ifndef PH_M3
#define PH_M3 1
#endif
#ifndef PH_M4
#define PH_M4 1
#endif
#ifndef PH_GP
#define PH_GP 1
#endif
#ifndef PH_GG
#define PH_GG 1
#endif
#ifndef PH_GO
#define PH_GO 1
#endif
#ifndef PH_NORM2
#define PH_NORM2 1
#endif
#ifndef PH_FFN
#define PH_FFN 1
#endif

struct Args { const float* in[N_IN]; float* out; unsigned char* ws; };
__global__ void __launch_bounds__(512, 2) fwd_kernel(Args a) {
    extern __shared__ __attribute__((aligned(16))) unsigned char lds_raw[];
    LAS unsigned char* lds = (LAS unsigned char*)lds_raw;
    int tid = threadIdx.x; const int bid = blockIdx.x, G = gridDim.x, NT = G * 512, NGW = G * 8;
    int lane, wave, gtid, gw;
#define REIDX() do { tid = threadIdx.x; asm volatile("" : "+v"(tid)); lane = tid & 63; wave = __builtin_amdgcn_readfirstlane(tid >> 6); gtid = bid * 512 + tid; gw = bid * 8 + wave; } while (0)
    REIDX();
    unsigned char* ws = (unsigned char*)in_tab()[N_IN + 1]; float* out = (float*)in_tab()[N_IN];
    if (tid < 4) ((LAS unsigned*)(lds + LDS_MISC))[tid] = 0u;
    __syncthreads();
    XcdBarrier bar = xcd_barrier_post((unsigned*)(ws + WS_CTL) + CW_BAR, (volatile LAS unsigned*)(lds + LDS_MISC));
#define GRID_BAR() do { XcdBarrier b2_ = bar; asm volatile("" : "+s"(b2_.x)); xcd_barrier(b2_); } while (0)
    float* MOD = (float*)(ws + WS_MOD);
    bf16_t* H = (bf16_t*)(ws + WS_H); bf16_t* PROJ = (bf16_t*)(ws + WS_PROJ); bf16_t* OB = (bf16_t*)(ws + WS_O); bf16_t* PB = (bf16_t*)(ws + WS_P); bf16_t* MG = (bf16_t*)(ws + WS_MG);
    bf16_t* XC = (bf16_t*)(ws + WS_XC); bf16_t* LAB = (bf16_t*)(ws + WS_LAB); bf16_t* SU2 = (bf16_t*)(ws + WS_SU2); bf16_t* YS = (bf16_t*)(ws + WS_YS);
    float* BU = (float*)(ws + WS_BU); bf16_t* HS = (bf16_t*)(ws + WS_HS); bf16_t* KV = (bf16_t*)(ws + WS_KV); bf16_t* SIN = (bf16_t*)(ws + WS_SIN);
    bf16_t* XB = (bf16_t*)(ws + WS_XB);

#if PH_PRO
    for (int rep = 0; rep < REP_PRO; ++rep) {
    REIDX();
    prologue_weights(in_tab(), ws, lds, gw, NGW, wave, lane);
    prologue_lru_w(in_tab(), ws, gtid, NT);
    __syncthreads();
    prologue_mod(in_tab(), ws, lds, bid, G, tid, wave, lane);
    prologue_ssm(in_tab(), ws, lds, (bid + 128) % G, G, tid);
    }
#endif
    GRID_BAR();

    for (int l = 0; l < DEPTH; ++l) {
        const float* modl = MOD + (size_t)l * 9 * 12288;
#if PH_NORM1
        for (int rep = 0; rep < REP_NORM1; ++rep) {
        REIDX();
        norm_phase(INP(I_XP), INP(I_XS), XB, l == 0, INP(I_NORM1) + l * D, modl, 0, 1, H, gw, NGW, lane);
        }
#endif
        GRID_BAR();
#if PH_GIN
        for (int rep = 0; rep < REP_GIN; ++rep) {
        REIDX();
        { pg8::Gemm g{H, (const bf16_t*)(ws + WS_WIN1) + (size_t)l * NPROJ * D, MTOK, NPROJ, D, D, D, 0, 0, 0, 0}; pg8::StaticOrder S; S.init(MTOK, NPROJ, G, bid);
          EpiStore E{PROJ, NPROJ, 0, (DRY_PROBE && rep < REP_GIN - 1) ? 1 : 0, SU2}; pg8::gemm_phase<EpiStore>(lds, g, S, E); }
        }
#endif
        GRID_BAR();
#if PH_M1
        REIDX();
        m1_attn_prep(PROJ, INP(I_QN) + l * 128, INP(I_KN) + l * 128, out, l, gtid, NT);
        for (int rep = 0; rep < REP_M1; ++rep) {
        REIDX();
        for (int r_ = 0; r_ < REP_M1A; ++r_) { m1_lru_conv(PROJ, XC, INP(I_LCW) + l * 4 * 512, INP(I_LCB) + l * 512, gtid, NT); }
        for (int r_ = 0; r_ < REP_M1B; ++r_) { for (int u = bid; u < 256; u += G) m1_ssm_bu(SU2, (const bf16_t*)(ws + WS_SSMB) + (size_t)l * 32 * 65536, BU, u, wave, lane); }
        for (int r_ = 0; r_ < REP_M1C; ++r_) { m1_ret_kv_all(PROJ, KV, INP(I_RDEC) + l * 8, lds, bid, G, tid, wave, lane); }
        }
#endif
        GRID_BAR();
#if PH_M2
        for (int rep = 0; rep < REP_M2; ++rep) {
        REIDX();
        for (int r_ = 0; r_ < REP_M2A; ++r_) { pg8::Gemm g{XC, (const bf16_t*)(ws + WS_WLRU) + (size_t)l * 2048 * 128, MTOK, 2048, 128, 512, 128, 0, 3, 128, 0}; pg8::StaticOrder S; S.init(MTOK, 2048, G, bid);
          EpiLru E{XC, LAB, PROJ, INP(I_LBA) + l * 1024, INP(I_LBX) + l * 1024, (const float*)(ws + WS_SPV) + l * 1024}; pg8::gemm_phase<EpiLru>(lds, g, S, E); }
        for (int r_ = 0; r_ < REP_M2B; ++r_) { for (int u = bid; u < 768; u += G) m2_attn_unit(PROJ, INP(I_CK), INP(I_CV), OB, INP(I_SINK) + l * 4, lds, u, l, tid, wave, lane); }
        for (int r_ = 0; r_ < REP_M2C; ++r_) { for (int it = bid; it < 320; it += G) m2_ssm_scan(BU, HS, (const float*)(ws + WS_A16) + (size_t)l * 2 * 32 * 64 * 2, INP(I_SSRE), INP(I_SSIM), out, l, it, tid); }
        for (int r_ = 0; r_ < REP_M2D; ++r_) { m2_ret_scan(KV, SIN, INP(I_SRET), INP(I_RDEC) + l * 8, out, l, gtid, NT); }
        }
#endif
        GRID_BAR();
#if PH_M3
        for (int rep = 0; rep < REP_M3; ++rep) {
        REIDX();
        for (int r_ = 0; r_ < REP_M3A; ++r_) { for (int t = bid; t < 512; t += G) m3_lru_scan(LAB, OB, INP(I_SLRU), out, lds, l, t, tid); }
        for (int r_ = 0; r_ < REP_M3B; ++r_) { for (int u = bid; u < 256; u += G) m3_ssm_y(SU2, (const bf16_t*)(ws + WS_SSMK) + (size_t)l * 32 * 65536, (const bf16_t*)(ws + WS_SSMC) + (size_t)l * 32 * 65536, HS, YS, u, wave, lane); }
        for (int r_ = 0; r_ < REP_M3C; ++r_) { m3_ret_out_all(PROJ, SIN, OB, INP(I_RDEC) + l * 8, INP(I_RGN) + l * 512, lds, bid, G, tid, wave, lane); }
        }
#endif
        GRID_BAR();
#if PH_M4
        for (int rep = 0; rep < REP_M4; ++rep) {
        REIDX();
        { pg8::Gemm g{YS, (const bf16_t*)(ws + WS_WGLU) + (size_t)l * 512 * 512, MTOK, 512, 512, 512, 512, 0, 0, 0, 0}; pg8::StaticOrder S; S.init(MTOK, 512, G, bid);
          EpiGlu E{YS, OB, INP(I_SBGLU) + l * 512}; pg8::gemm_phase<EpiGlu>(lds, g, S, E); }
        }
#endif
        GRID_BAR();
#if PH_GP
        for (int rep = 0; rep < REP_GP; ++rep) {
        REIDX();
        { pg8::Gemm g{OB, (const bf16_t*)(ws + WS_WBR) + (size_t)l * 8192 * 512, MTOK, 8192, 512, D, 512, 3, 0xffff, 512, 0}; pg8::StaticOrder S; S.init(MTOK, 8192, G, bid);
          EpiStore E{PB, 8192, 0, 0, nullptr}; pg8::gemm_phase<EpiStore>(lds, g, S, E); }
        }
#endif
        GRID_BAR();
#if PH_GG
        for (int rep = 0; rep < REP_GG; ++rep) {
        REIDX();
        { pg8::Gemm g{H, (const bf16_t*)(ws + WS_WGATE) + (size_t)l * 8192 * D, MTOK, 8192, D, D, D, 0, 0, 0, 0}; pg8::StaticOrder S; S.init(MTOK, 8192, G, bid);
          EpiGate E{PB, MG}; pg8::gemm_phase<EpiGate>(lds, g, S, E); }
        }
#endif
        GRID_BAR();
#if PH_GO
        for (int rep = 0; rep < REP_GO; ++rep) {
        REIDX();
        { pg8::Gemm g{MG, (const bf16_t*)(ws + WS_WOUT) + (size_t)l * D * D, MTOK, D, D, D, D, 0, 0, 0, 0}; pg8::StaticOrder S; S.init(MTOK, D, G, bid);
          EpiResid E{XB, XB, nullptr, modl + 2 * 2048, rep < REP_GO - 1 ? 1 : 0}; pg8::gemm_phase<EpiResid>(lds, g, S, E); }
        }
#endif
        GRID_BAR();
#if PH_NORM2
        for (int rep = 0; rep < REP_NORM2; ++rep) {
        REIDX();
        norm_phase(nullptr, nullptr, XB, false, INP(I_NORM2) + l * D, modl, 3, 4, H, gw, NGW, lane);
        }
#endif
        GRID_BAR();
#if PH_FFN
        for (int rep = 0; rep < REP_FF1; ++rep) {
        REIDX();
        { pg8::Gemm g{H, (const bf16_t*)(ws + WS_WFF1) + (size_t)l * DFF * D, MTOK, DFF, D, D, D, 0, 0, 0, 0}; pg8::StaticOrder S; S.init(MTOK, DFF, G, bid);
          EpiStore E{PB, DFF, 1, 0, nullptr}; pg8::gemm_phase<EpiStore>(lds, g, S, E); }
        }
        GRID_BAR();
        for (int rep = 0; rep < REP_FF2; ++rep) {
        REIDX();
        { pg8::Gemm g{PB, (const bf16_t*)(ws + WS_WFF2) + (size_t)l * D * DFF, MTOK, D, DFF, DFF, DFF, 0, 0, 0, (HOT_PROBE && rep < REP_FF2 - 1) ? 1 : 0}; pg8::StaticOrder S; S.init(MTOK, D, G, bid);
          EpiResid E{XB, XB, l == DEPTH - 1 ? out : nullptr, modl + 5 * 2048, rep < REP_FF2 - 1 ? 1 : 0}; pg8::gemm_phase<EpiResid>(lds, g, S, E); }
        }
        GRID_BAR();
#endif
    }
}

extern "C" void kernel_launch(void* const* d_in, const int* in_sizes, int n_in, void* d_out, int out_size, void* d_ws, size_t ws_size, hipStream_t stream) {
    static int grid = 0;
    if (grid == 0) {
        if (n_in != N_IN || (size_t)out_size != O_END || ws_size < WS_END) { fprintf(stderr, "kernel_launch: unexpected shapes (n_in %d, out %d, ws %zu; need ws >= %zu)\n", n_in, out_size, ws_size, (size_t)WS_END); grid = -1; return; }
        int dev = 0, cus = 0;
        if (hipGetDevice(&dev) != hipSuccess || hipDeviceGetAttribute(&cus, hipDeviceAttributeMultiprocessorCount, dev) != hipSuccess) { grid = -1; return; }
        if (hipFuncSetAttribute((const void*)fwd_kernel, hipFuncAttributeMaxDynamicSharedMemorySize, LDS_BYTES) != hipSuccess) { fprintf(stderr, "kernel_launch: hipFuncSetAttribute failed\n"); grid = -1; return; }
        int per_cu = 0;
        if (hipOccupancyMaxActiveBlocksPerMultiprocessor(&per_cu, (const void*)fwd_kernel, 512, LDS_BYTES) != hipSuccess || per_cu < 1) { fprintf(stderr, "kernel_launch: occupancy query says %d blocks per CU\n", per_cu); grid = -1; (void)hipGetLastError(); return; }
        grid = cus;
    }
    if (grid < 0) return;
    (void)hipMemsetAsync((char*)d_ws + WS_CTL, 0, CTL_ZERO_BYTES, stream);
    Args a{};
    for (int i = 0; i < N_IN; ++i) a.in[i] = (const float*)d_in[i];
    a.out = (float*)d_out; a.ws = (unsigned char*)d_ws;
    hipLaunchKernelGGL(fwd_kernel, dim3(grid), dim3(512), LDS_BYTES, stream, a);
}
```
